# Optimizing an MI355X kernel written in HIP

```python
import math
import jax, jax.numpy as jnp
from jax import lax
import numpy as np


D_MODEL = 2048
BATCH = 4
SEQ = 4096
DEPTH = 1

MEM_LEN = 256
EPS = 1e-6
DA_HEADS = 4
DA_HEAD_DIM = D_MODEL // (4 * DA_HEADS)
DA_WIDTH = DA_HEADS * 2 * DA_HEAD_DIM
Q_BLOCK = 128
HG_HEADS = 8
HG_KEY_DIM = 128
HG_VAL_DIM = D_MODEL // (2 * HG_HEADS)
HG_QK = HG_HEADS * HG_KEY_DIM
HG_WIDTH = HG_HEADS * HG_VAL_DIM
HG_CHUNK = 64
XA_HEADS = 4
XA_HEAD_DIM = D_MODEL // (2 * XA_HEADS)
XA_WIDTH = XA_HEADS * XA_HEAD_DIM
N_BRANCH = 3
IN_SIZES = (DA_WIDTH, DA_WIDTH, DA_WIDTH, HG_QK, HG_QK, HG_WIDTH, HG_WIDTH, XA_WIDTH, N_BRANCH * D_MODEL)
IN_COLS = 3 * DA_WIDTH + 2 * HG_QK + 2 * HG_WIDTH + XA_WIDTH + N_BRANCH * D_MODEL
D_FF = 5632

kernel_name = "hybrid_diffattn_hgrn2_memxattn_macaron"


def rmsnorm(x, g):
    xf = x.astype(jnp.float32)
    y = xf * lax.rsqrt(jnp.mean(xf * xf, axis=-1, keepdims=True) + EPS)
    return (y * g.astype(jnp.float32)).astype(x.dtype)


def swiglu(x, w_gate, w_up, w_down):
    return (jax.nn.silu(x @ w_gate) * (x @ w_up)) @ w_down


def alibi_slopes(n):
    return jnp.array([2.0 ** (-8.0 * (i + 1) / n) for i in range(n)], dtype=jnp.float32)


def split_cols(t, sizes):
    out, start = [], 0
    for n in sizes:
        out.append(t[..., start:start + n])
        start += n
    return out


def diff_attention(q, k, v, lam_q1, lam_k1, lam_q2, lam_k2, subln_g, lambda_init):
    B, S, _ = q.shape
    f32 = jnp.float32
    q = q.reshape(B, S, DA_HEADS, 2, DA_HEAD_DIM) * (DA_HEAD_DIM ** -0.5)
    k = k.reshape(B, S, DA_HEADS, 2, DA_HEAD_DIM)
    v = v.reshape(B, S, DA_HEADS, 2 * DA_HEAD_DIM)
    lam = (jnp.exp(jnp.sum(lam_q1.astype(f32) * lam_k1.astype(f32)))
           - jnp.exp(jnp.sum(lam_q2.astype(f32) * lam_k2.astype(f32))) + lambda_init)
    slopes = alibi_slopes(DA_HEADS)
    n_blocks = S // Q_BLOCK
    q_blocks = q.reshape(B, n_blocks, Q_BLOCK, DA_HEADS, 2, DA_HEAD_DIM).transpose(1, 0, 2, 3, 4, 5)
    k_pos = jnp.arange(S)

    def one_block(args):
        q_blk, blk = args
        s = jnp.einsum('bqhcd,bkhcd->bhcqk', q_blk, k, preferred_element_type=f32)
        q_pos = blk * Q_BLOCK + jnp.arange(Q_BLOCK)
        dist = q_pos[:, None] - k_pos[None, :]
        bias = -slopes[:, None, None] * dist.astype(f32)[None]
        s = jnp.where((dist >= 0)[None, None, None], s + bias[None, :, None], -jnp.inf)
        p = jax.nn.softmax(s, axis=-1)
        a = p[:, :, 0] - lam * p[:, :, 1]
        return jnp.einsum('bhqk,bkhe->bqhe', a.astype(v.dtype), v)

    o = lax.map(one_block, (q_blocks, jnp.arange(n_blocks)))
    o = o.transpose(1, 0, 2, 3, 4).reshape(B, S, DA_HEADS, 2 * DA_HEAD_DIM)
    o = rmsnorm(o, subln_g) * (1.0 - lambda_init)
    return o.reshape(B, S, DA_WIDTH)


def hgrn2(q, f_logit, i_in, o_gate, lb, norm_g):
    B, S, _ = q.shape
    dt = i_in.dtype
    f32 = jnp.float32
    z = f_logit.astype(f32).reshape(B, S, HG_HEADS, HG_KEY_DIM)
    lb = lb.astype(f32).reshape(HG_HEADS, HG_KEY_DIM)
    log_f = jnp.log(lb + (1.0 - lb) * jax.nn.sigmoid(z))
    kk = (1.0 - lb) * jax.nn.sigmoid(-z)
    qf = jax.nn.silu(q.astype(f32)).reshape(B, S, HG_HEADS, HG_KEY_DIM)
    v = i_in.astype(f32).reshape(B, S, HG_HEADS, HG_VAL_DIM)
    n_chunks = S // HG_CHUNK

    def chunked(t):
        return t.reshape(B, n_chunks, HG_CHUNK, HG_HEADS, t.shape[-1]).transpose(1, 0, 3, 2, 4)

    causal = jnp.tril(jnp.ones((HG_CHUNK, HG_CHUNK), dtype=bool))[:, :, None]

    def step(state, xs):
        qc, kc, gc, vc = xs
        b = lax.cumsum(gc, axis=2)
        pair = b[:, :, :, None, :] - b[:, :, None, :, :]
        decay = jnp.where(causal, jnp.exp(jnp.where(causal, pair, 0.0)), 0.0)
        scores = jnp.einsum('bhtsk,bhsk->bhts', qc[:, :, :, None, :] * decay, kc)
        o = (jnp.einsum('bhts,bhsv->bhtv', scores, vc)
             + jnp.einsum('bhtk,bhkv->bhtv', qc * jnp.exp(b), state))
        b_end = b[:, :, -1:, :]
        state = (jnp.exp(b_end[:, :, 0, :])[..., None] * state
                 + jnp.einsum('bhsk,bhsv->bhkv', kc * jnp.exp(b_end - b), vc))
        return state, o

    state0 = jnp.zeros((B, HG_HEADS, HG_KEY_DIM, HG_VAL_DIM), f32)
    _, o = lax.scan(step, state0, (chunked(qf), chunked(kk), chunked(log_f), chunked(v)))
    o = o.transpose(1, 0, 3, 2, 4).reshape(B, S, HG_HEADS, HG_VAL_DIM)
    o = o * lax.rsqrt(jnp.mean(o * o, axis=-1, keepdims=True) + EPS) * norm_g.astype(f32).reshape(HG_HEADS, HG_VAL_DIM)
    o = o * jax.nn.sigmoid(o_gate.astype(f32)).reshape(B, S, HG_HEADS, HG_VAL_DIM)
    return o.reshape(B, S, HG_WIDTH).astype(dt)


def memory_cross_attention(q, mem_n, w_mem_kv):
    B, S, _ = q.shape
    f32 = jnp.float32
    kv = mem_n @ w_mem_kv
    k, v = kv[..., :XA_WIDTH], kv[..., XA_WIDTH:]
    q = q.reshape(B, S, XA_HEADS, XA_HEAD_DIM) * (XA_HEAD_DIM ** -0.5)
    k = k.reshape(B, -1, XA_HEADS, XA_HEAD_DIM)
    v = v.reshape(B, -1, XA_HEADS, XA_HEAD_DIM)
    s = jnp.einsum('bqhd,bmhd->bhqm', q, k, preferred_element_type=f32)
    p = jax.nn.softmax(s, axis=-1)
    o = jnp.einsum('bhqm,bmhd->bqhd', p.astype(v.dtype), v)
    return o.reshape(B, S, XA_WIDTH)


def setup_inputs(seed: int = 0) -> dict:
    key = jax.random.key(seed)
    ks = jax.random.split(key, 32)
    f32 = jnp.float32
    L = DEPTH

    def nrm(k, shape, scale):
        return jax.random.normal(k, shape, f32) * scale

    def gain(k, shape):
        return 1.0 + 0.02 * jax.random.normal(k, shape, f32)

    return {
        'x': nrm(ks[0], (BATCH, SEQ, D_MODEL), 1.0),
        'mem': nrm(ks[1], (BATCH, MEM_LEN, D_MODEL), 1.0),
        'ffn1_norm': gain(ks[2], (L, D_MODEL)),
        'ffn1_w_gate': nrm(ks[3], (L, D_MODEL, D_FF), D_MODEL ** -0.5),
        'ffn1_w_up': nrm(ks[4], (L, D_MODEL, D_FF), D_MODEL ** -0.5),
        'ffn1_w_down': nrm(ks[5], (L, D_FF, D_MODEL), D_FF ** -0.5),
        'mix_norm': gain(ks[6], (L, D_MODEL)),
        'mem_norm': gain(ks[7], (L, D_MODEL)),
        'w_in': nrm(ks[8], (L, D_MODEL, IN_COLS), D_MODEL ** -0.5),
        'da_lambda_q1': nrm(ks[9], (L, DA_HEAD_DIM), 0.1),
        'da_lambda_k1': nrm(ks[10], (L, DA_HEAD_DIM), 0.1),
        'da_lambda_q2': nrm(ks[11], (L, DA_HEAD_DIM), 0.1),
        'da_lambda_k2': nrm(ks[12], (L, DA_HEAD_DIM), 0.1),
        'da_subln': gain(ks[13], (L, 2 * DA_HEAD_DIM)),
        'hg_lb_logits': nrm(ks[14], (L + 1, HG_QK), 0.1),
        'hg_norm': gain(ks[15], (L, HG_WIDTH)),
        'w_mem_kv': nrm(ks[16], (L, D_MODEL, 2 * XA_WIDTH), D_MODEL ** -0.5),
        'w_branch_da': nrm(ks[17], (L, DA_WIDTH, D_MODEL), DA_WIDTH ** -0.5),
        'w_branch_hg': nrm(ks[18], (L, HG_WIDTH, D_MODEL), HG_WIDTH ** -0.5),
        'w_branch_xa': nrm(ks[19], (L, XA_WIDTH, D_MODEL), XA_WIDTH ** -0.5),
        'w_out': nrm(ks[20], (L, D_MODEL, D_MODEL), D_MODEL ** -0.5),
        'ffn2_norm': gain(ks[21], (L, D_MODEL)),
        'ffn2_w_gate': nrm(ks[22], (L, D_MODEL, D_FF), D_MODEL ** -0.5),
        'ffn2_w_up': nrm(ks[23], (L, D_MODEL, D_FF), D_MODEL ** -0.5),
        'ffn2_w_down': nrm(ks[24], (L, D_FF, D_MODEL), D_FF ** -0.5),
        'final_norm': gain(ks[25], (D_MODEL,)),
    }


def reference(x, mem, ffn1_norm, ffn1_w_gate, ffn1_w_up, ffn1_w_down, mix_norm, mem_norm, w_in,
              da_lambda_q1, da_lambda_k1, da_lambda_q2, da_lambda_k2, da_subln, hg_lb_logits, hg_norm,
              w_mem_kv, w_branch_da, w_branch_hg, w_branch_xa, w_out,
              ffn2_norm, ffn2_w_gate, ffn2_w_up, ffn2_w_down, final_norm):
    B, S, D = x.shape
    lower_bounds = jnp.cumsum(jax.nn.softmax(hg_lb_logits.astype(jnp.float32), axis=0), axis=0)
    h = x
    for l in range(DEPTH):
        lambda_init = 0.8 - 0.6 * math.exp(-0.3 * l)
        h = h + 0.5 * swiglu(rmsnorm(h, ffn1_norm[l]), ffn1_w_gate[l], ffn1_w_up[l], ffn1_w_down[l])
        u = rmsnorm(h, mix_norm[l])
        proj = u @ w_in[l]
        da_q, da_k, da_v, hg_q, hg_f, hg_i, hg_g, xa_q, gate_logits = split_cols(proj, IN_SIZES)
        y_da = diff_attention(da_q, da_k, da_v, da_lambda_q1[l], da_lambda_k1[l], da_lambda_q2[l],
                              da_lambda_k2[l], da_subln[l], lambda_init)
        y_hg = hgrn2(hg_q, hg_f, hg_i, hg_g, lower_bounds[l], hg_norm[l])
        y_xa = memory_cross_attention(xa_q, rmsnorm(mem, mem_norm[l]), w_mem_kv[l])
        gates = jax.nn.sigmoid(gate_logits.astype(jnp.float32)).astype(h.dtype).reshape(B, S, N_BRANCH, D)
        merged = (gates[:, :, 0] * (y_da @ w_branch_da[l])
                  + gates[:, :, 1] * (y_hg @ w_branch_hg[l])
                  + gates[:, :, 2] * (y_xa @ w_branch_xa[l]))
        h = h + merged @ w_out[l]
        h = h + 0.5 * swiglu(rmsnorm(h, ffn2_norm[l]), ffn2_w_gate[l], ffn2_w_up[l], ffn2_w_down[l])
    return rmsnorm(h, final_norm)
```

```cpp
#include <hip/hip_runtime.h>
#include <hip/hip_bf16.h>
#include <hip/hip_cooperative_groups.h>
#include <cstdio>
#include <cstdint>
namespace cg = cooperative_groups;

#define LAS __attribute__((address_space(3)))
typedef unsigned short bf16_t;
typedef short bf16x8 __attribute__((ext_vector_type(8)));
typedef short s16x4 __attribute__((ext_vector_type(4)));
typedef float f32x4 __attribute__((ext_vector_type(4)));
typedef float f32x16 __attribute__((ext_vector_type(16)));
typedef unsigned u32x4 __attribute__((ext_vector_type(4)));
typedef unsigned u32x2 __attribute__((ext_vector_type(2)));
typedef int i32x4 __attribute__((ext_vector_type(4)));

constexpr int DM = 2048, NB = 4, SEQ = 4096, MTOK = NB * SEQ, MEMLEN = 256, DFF = 5632, INCOLS = 14336;
constexpr int HROWS = MTOK / 2;
constexpr float EPS = 1e-6f;
constexpr float LOG2E = 1.4426950408889634f;

constexpr size_t MiB = 1u << 20;
constexpr size_t WS_SSQ = 0;
constexpr size_t WS_LB = 256 * 1024, WS_LAM = 260 * 1024;
constexpr size_t WS_HGD = 512 * 1024;
constexpr size_t WS_CTL = 1 * MiB, CTL_BYTES = 192 * 1024;
constexpr size_t WS_CMAX1 = WS_CTL + 16384, WS_CMAX2 = WS_CTL + 65536, WS_CMAXG = WS_CTL + 112 * 1024, WS_CS1 = WS_CTL + 192 * 1024, WS_CS2 = WS_CTL + 240 * 1024, WS_CSG = WS_CTL + 288 * 1024;
constexpr size_t WS_XA8G = 48 * MiB;
constexpr size_t WS_MEMN = 2 * MiB, WS_KMEM = 6 * MiB, WS_VTM = 8 * MiB;
constexpr size_t WS_WGU = 16 * MiB, WS_WD = 60 * MiB;
constexpr size_t WS_PSCR = 16 * MiB;
constexpr size_t WS_WIN = 82 * MiB, WS_WMK = 138 * MiB, WS_WBR = 146 * MiB, WS_WO = 158 * MiB;
constexpr size_t WS_XA = 166 * MiB;
constexpr size_t WS_BIG = 230 * MiB;
constexpr size_t WS_DQ = WS_BIG, WS_DK = WS_BIG + 16 * MiB, WS_DV = WS_BIG + 32 * MiB, WS_HQ = WS_BIG + 48 * MiB, WS_HK = WS_BIG + 64 * MiB,
                 WS_HV = WS_BIG + 80 * MiB, WS_HG = WS_BIG + 96 * MiB, WS_HLF = WS_BIG + 112 * MiB, WS_XQ = WS_BIG + 144 * MiB, WS_GT = WS_BIG + 160 * MiB;
constexpr size_t WS_OB = 486 * MiB, WS_HGS = 518 * MiB, WS_END = 550 * MiB;
constexpr size_t WS_HID = WS_BIG, WS_XB = WS_BIG + 176 * MiB;
static_assert(WS_XB + 64 * MiB <= WS_END, "ws map");

constexpr int LDS_BYTES = 160 * 1024;
constexpr int LDS_MISC = LDS_BYTES - 64;
#define TESTMODE 0
#define TESTSKIP 0
#define TESTCONSTL 0
#define TESTNOSTATE 0
#define TESTZEROST 0
#define TESTSANST 0
#define TESTSANITIZE 0
#define TESTCHAIN 0

typedef float f32x2_t __attribute__((ext_vector_type(2)));
typedef __bf16 bf16x2_t __attribute__((ext_vector_type(2)));
__device__ __forceinline__ unsigned cvt_pk_bf16(float lo, float hi) { f32x2_t v = {lo, hi}; bf16x2_t b = __builtin_convertvector(v, bf16x2_t); return __builtin_bit_cast(unsigned, b); }
__device__ __forceinline__ float bf_lo(unsigned w) { return __uint_as_float(w << 16); }
__device__ __forceinline__ float bf_hi(unsigned w) { return __uint_as_float(w & 0xffff0000u); }
__device__ __forceinline__ float fexp(float x) { return __builtin_amdgcn_exp2f(x * LOG2E); }
__device__ __forceinline__ float fsigmoid(float x) { return __builtin_amdgcn_rcpf(1.0f + fexp(-x)); }
__device__ __forceinline__ float fsilu(float x) { return x * fsigmoid(x); }
__device__ __forceinline__ u32x4 pack8(f32x4 a, f32x4 b) { u32x4 w; w.x = cvt_pk_bf16(a[0], a[1]); w.y = cvt_pk_bf16(a[2], a[3]); w.z = cvt_pk_bf16(b[0], b[1]); w.w = cvt_pk_bf16(b[2], b[3]); return w; }
__device__ __forceinline__ void unpack8(u32x4 w, f32x4& a, f32x4& b) { a = (f32x4){bf_lo(w.x), bf_hi(w.x), bf_lo(w.y), bf_hi(w.y)}; b = (f32x4){bf_lo(w.z), bf_hi(w.z), bf_lo(w.w), bf_hi(w.w)}; }
__device__ __forceinline__ float wave_sum(float v) {
#pragma unroll
    for (int o = 1; o < 64; o <<= 1) v += __shfl_xor(v, o);
    return v;
}

namespace pg8 {
constexpr int BM = 256, BK = 64, HALF = 128, HTB = HALF * BK * 2, STAGE_BYTES = 8 * HTB, NXCD = 8, WGM = 8;
__host__ __device__ __forceinline__ int lds_byte(int r, int c) { const int st = (r >> 4) * 2 + (c >> 5), rr = r & 15, cc = c & 31, ob = rr * 64 + cc * 2; return st * 1024 + (ob ^ (((ob >> 9) & 1) << 5)); }
__host__ __device__ __forceinline__ void stage_rc(int b, int& R, int& C) { const int st = b / 1024, sb = b % 1024, swz = sb ^ (((sb >> 9) & 1) << 5); R = (st >> 1) * 16 + swz / 64; C = (st & 1) * 32 + (swz % 64) / 2; }
__host__ __device__ __forceinline__ int perm32(int rho) { const int n = rho >> 4, i = rho & 15; return 8 * (i >> 2) + 4 * n + (i & 3); }

struct Unit { const char* A; const char* B; int pm, pn, sub, keep; };

struct TileOrder {
    int nM, nN, nwg, G, c;
    __device__ void init(int nM_, int nN_, int G_, int c_) { nM = nM_; nN = nN_; nwg = nM * nN; G = G_; c = c_; }
    __device__ bool tile(long L, int& pm, int& pn) const {
        if (L >= nwg) return false;
        int wgid = (int)L; { const int q = nwg / NXCD, r = nwg % NXCD, xcd = wgid % NXCD, off = wgid / NXCD; wgid = (xcd < r ? xcd * (q + 1) : r * (q + 1) + (xcd - r) * q) + off; }
        const int nig = WGM * nN, gid = wgid / nig, fm = gid * WGM, gsz = (nM - fm) < WGM ? (nM - fm) : WGM;
        pm = fm + ((wgid % nig) % gsz); pn = (wgid % nig) / gsz; return true;
    }
};
struct StdOrder {
    TileOrder T; const char* A; const char* B; size_t a_t, b_t;
    __device__ bool next(int i, Unit& u) const { int pm, pn; if (!T.tile((long)i * T.G + T.c, pm, pn)) return false; u.pm = pm; u.pn = pn; u.sub = 0; u.keep = 0; u.A = A + (size_t)pm * a_t; u.B = B + (size_t)pn * b_t; return true; }
};
struct ChainOrder {
    TileOrder T; const char* A; const char* B; size_t a_sub, b_sub, a_t, b_t;
    __device__ bool next(int i, Unit& u) const {
#if TESTCHAIN >= 1
        const int ti = i, sub = (TESTCHAIN == 1) ? 2 : (TESTCHAIN - 2);
#else
        const int ti = i / 3, sub = i - 3 * ti;
#endif
        int pm, pn; if (!T.tile((long)ti * T.G + T.c, pm, pn)) return false; u.pm = pm; u.pn = pn; u.sub = sub; u.keep = 0;
        u.A = A + a_sub * (size_t)((sub * (sub + 1)) >> 1) + (size_t)pm * a_t; u.B = B + b_sub * (size_t)sub + (size_t)pn * b_t; return true; }
};
struct OneUnit {
    Unit u0; bool have;
    __device__ bool next(int i, Unit& u) const { if (i != 0 || !have) return false; u = u0; return true; }
};

template <class Epi, class Sched, bool ALIGN_EPI, bool I8 = false>
__device__ __forceinline__ void gemm_phase(LAS unsigned char* lds, const int K, const int lda, const int ldb, const Sched& S, const Epi& E) {
    int tid = threadIdx.x; asm volatile("" : "+v"(tid));
    const int wid = __builtin_amdgcn_readfirstlane(tid >> 6), lane = tid & 63, wr = wid >> 2, wc = wid & 3, fr = lane & 15, fq = lane >> 4;
    int nt = K / BK; asm volatile("" : "+s"(nt));
    unsigned voffA[2], voffB[2];
#pragma unroll
    for (int i = 0; i < 2; ++i) { int R, C; stage_rc(tid * 16 + i * 8192, R, C); const int Rb = (R & ~31) + perm32(R & 31);
        voffA[i] = (unsigned)(R * lda + C) * 2u; voffB[i] = (unsigned)(Rb * ldb + C) * 2u; }
    const size_t kstep = (size_t)(BK * 2);
    const size_t hstepA = (size_t)HALF * lda * 2, hstepB = (size_t)HALF * ldb * 2;
    const unsigned ldsw = (unsigned)wid * 1024u;
    const int aoff = lds_byte(wr * 64 + fr, fq * 8), boff = lds_byte(wc * 32 + fr, fq * 8);
#define PG8_SA(b, h) (((b) * 2 + (h)) * HTB)
#define PG8_SB(b, h) ((4 + (b) * 2 + (h)) * HTB)
#define PG8_STAGE(bufoff, gbase, voff) do { _Pragma("unroll") for (int _i = 0; _i < 2; ++_i) \
        __builtin_amdgcn_global_load_lds((const unsigned*)((const char*)(gbase) + (voff)[_i]), (LAS unsigned*)(lds + (bufoff) + ldsw + _i * 8192), 16, 0, 0); } while (0)
#define PG8_LDA(dst, b, h) do { _Pragma("unroll") for (int m = 0; m < 4; ++m) _Pragma("unroll") for (int k = 0; k < 2; ++k) dst[m][k] = *(const LAS bf16x8*)(lds + PG8_SA(b, h) + aoff + m * 2048 + k * 1024); } while (0)
#define PG8_LDB(dst, b, h) do { _Pragma("unroll") for (int n = 0; n < 2; ++n) _Pragma("unroll") for (int k = 0; k < 2; ++k) dst[n][k] = *(const LAS bf16x8*)(lds + PG8_SB(b, h) + boff + n * 2048 + k * 1024); } while (0)
#define PG8_MMA(ai, bj, At, Bt) do { __builtin_amdgcn_s_setprio(1); _Pragma("unroll") for (int m = 0; m < 4; ++m) _Pragma("unroll") for (int n = 0; n < 2; ++n) _Pragma("unroll") for (int k = 0; k < 2; ++k) \
        { if constexpr (I8) acc[ai][bj][m][n] = __builtin_bit_cast(f32x4, __builtin_amdgcn_mfma_i32_16x16x64_i8(__builtin_bit_cast(i32x4, Bt[n][k]), __builtin_bit_cast(i32x4, At[m][k]), __builtin_bit_cast(i32x4, acc[ai][bj][m][n]), 0, 0, 0)); \
          else acc[ai][bj][m][n] = __builtin_amdgcn_mfma_f32_16x16x32_bf16(Bt[n][k], At[m][k], acc[ai][bj][m][n], 0, 0, 0); } __builtin_amdgcn_s_setprio(0); } while (0)
#define PG8_WAIT_V(n) asm volatile("s_waitcnt vmcnt(" #n ")" ::: "memory")
#define PG8_WAIT_L(n) asm volatile("s_waitcnt lgkmcnt(" #n ")" ::: "memory")
#define PG8_BAR __builtin_amdgcn_s_barrier()
#define PG8_SCHED __builtin_amdgcn_sched_barrier(0)
    Unit cur, nxt; int ui = 0;
    if (!S.next(0, cur)) return;
    f32x4 acc[2][2][4][2];
#pragma unroll
    for (int a = 0; a < 2; ++a)
#pragma unroll
        for (int b = 0; b < 2; ++b)
#pragma unroll
            for (int m = 0; m < 4; ++m)
#pragma unroll
                for (int n = 0; n < 2; ++n) acc[a][b][m][n] = (f32x4){0.f, 0.f, 0.f, 0.f};
    bf16x8 At[4][2], B0[2][2], B1[2][2];
    const char* cA = cur.A; const char* cB = cur.B;
    PG8_STAGE(PG8_SB(0, 0), cB, voffB); PG8_STAGE(PG8_SB(0, 1), cB + hstepB, voffB); PG8_STAGE(PG8_SA(0, 0), cA, voffA); PG8_STAGE(PG8_SA(0, 1), cA + hstepA, voffA);
    if (wr == 1) PG8_BAR;
    PG8_WAIT_V(2); PG8_BAR;
    PG8_STAGE(PG8_SB(1, 0), cB + kstep, voffB); PG8_STAGE(PG8_SA(1, 0), cA + kstep, voffA); PG8_STAGE(PG8_SB(1, 1), cB + hstepB + kstep, voffB);
    PG8_WAIT_V(6); PG8_BAR;
    for (;;) {
        const bool has_next = S.next(ui + 1, nxt);
        const char* nA = has_next ? nxt.A : cA; const char* nB = has_next ? nxt.B : cB;
#pragma unroll 1
        for (int t = 0; t < nt; t += 2) {
            const bool last = (t == nt - 2);
            const char* a1 = cA + (size_t)(t + 1) * kstep;
            const char* a2 = last ? nA : cA + (size_t)(t + 2) * kstep; const char* b2 = last ? nB : cB + (size_t)(t + 2) * kstep;
            const char* a3 = a2 + kstep; const char* b3 = b2 + kstep;
            PG8_LDB(B0, 0, 0); PG8_LDB(B1, 0, 1); PG8_SCHED; PG8_LDA(At, 0, 0); PG8_STAGE(PG8_SA(1, 1), a1 + hstepA, voffA);
            PG8_WAIT_V(8); PG8_WAIT_L(0); PG8_BAR; PG8_MMA(0, 0, At, B0); PG8_MMA(0, 1, At, B1); PG8_BAR; PG8_SCHED;
            PG8_LDA(At, 0, 1); PG8_STAGE(PG8_SB(0, 0), b2, voffB); PG8_STAGE(PG8_SB(0, 1), b2 + hstepB, voffB); PG8_STAGE(PG8_SA(0, 0), a2, voffA);
            PG8_WAIT_V(8); PG8_WAIT_L(0); PG8_BAR; PG8_MMA(1, 0, At, B0); PG8_MMA(1, 1, At, B1); PG8_BAR; PG8_SCHED;
            PG8_LDB(B0, 1, 0); PG8_LDB(B1, 1, 1); PG8_SCHED; PG8_LDA(At, 1, 0); PG8_STAGE(PG8_SA(0, 1), a2 + hstepA, voffA);
            PG8_WAIT_V(8); PG8_WAIT_L(0); PG8_BAR; PG8_MMA(0, 0, At, B0); PG8_MMA(0, 1, At, B1); PG8_BAR; PG8_SCHED;
            PG8_LDA(At, 1, 1); PG8_STAGE(PG8_SB(1, 0), b3, voffB); PG8_STAGE(PG8_SB(1, 1), b3 + hstepB, voffB); PG8_STAGE(PG8_SA(1, 0), a3, voffA);
            PG8_WAIT_V(8); PG8_WAIT_L(0); PG8_BAR; PG8_MMA(1, 0, At, B0); PG8_MMA(1, 1, At, B1); PG8_BAR; PG8_SCHED;
        }
        if constexpr (ALIGN_EPI) { if (wr == 0) PG8_BAR; }
        if constexpr (!Epi::AFTER_DRAIN) { E(acc, cur, wr, wc, fr, fq); }
        if (!has_next) break;
        if (!nxt.keep) {
#pragma unroll
            for (int a = 0; a < 2; ++a)
#pragma unroll
                for (int b = 0; b < 2; ++b)
#pragma unroll
                    for (int m = 0; m < 4; ++m)
#pragma unroll
                        for (int n = 0; n < 2; ++n) acc[a][b][m][n] = (f32x4){0.f, 0.f, 0.f, 0.f};
        }
        cur = nxt; cA = nA; cB = nB; ++ui;
        if constexpr (ALIGN_EPI) { if (wr == 1) PG8_BAR; }
    }
    PG8_WAIT_V(0);
    if constexpr (!ALIGN_EPI) { if (wr == 0) PG8_BAR; }
    PG8_BAR;
    if constexpr (Epi::AFTER_DRAIN) { E.fused(acc, cur, wr, wc, fr, fq, lds, wid, lane); }
#undef PG8_SA
#undef PG8_SB
#undef PG8_STAGE
#undef PG8_LDA
#undef PG8_LDB
#undef PG8_MMA
#undef PG8_WAIT_V
#undef PG8_WAIT_L
#undef PG8_BAR
#undef PG8_SCHED
}

typedef f32x4 Acc[2][2][4][2];
#define EPI_ROWLOOP _Pragma("unroll") for (int ai = 0; ai < 2; ++ai) _Pragma("unroll") for (int m = 0; m < 4; ++m)

struct EpiUp {
    static constexpr bool AFTER_DRAIN = false;
    bf16_t* hid; const float* ssq;
    __device__ __forceinline__ void operator()(Acc& acc, const Unit& u, int wr, int wc, int fr, int fq) const {
        EPI_ROWLOOP { const int row = u.pm * BM + ai * HALF + wr * 64 + m * 16 + fr; const float r = rsqrtf(ssq[row] * (1.0f / DM) + EPS);
            f32x4 h[2];
#pragma unroll
            for (int n = 0; n < 2; ++n) { const f32x4 g = acc[ai][0][m][n] * r, up = acc[ai][1][m][n] * r;
#pragma unroll
                for (int j = 0; j < 4; ++j) h[n][j] = fsilu(g[j]) * up[j]; }
            *(u32x4*)(hid + (size_t)row * DFF + u.pn * 128 + wc * 32 + fq * 8) = pack8(h[0], h[1]); }
    }
};
struct EpiUp8 {
    static constexpr bool AFTER_DRAIN = false;
    bf16_t* hid; const float* cs; const float* rs;
    __device__ __forceinline__ void operator()(Acc& acc, const Unit& u, int wr, int wc, int fr, int fq) const {
        const int cb = u.pn * BM + wc * 32 + fq * 8;
        f32x4 sg[2], su[2];
#pragma unroll
        for (int n = 0; n < 2; ++n) { sg[n] = *(const f32x4*)(cs + cb + 4 * n); su[n] = *(const f32x4*)(cs + cb + HALF + 4 * n); }
        EPI_ROWLOOP { const int row = u.pm * BM + ai * HALF + wr * 64 + m * 16 + fr; const float r = rs[row];
            f32x4 h[2];
#pragma unroll
            for (int n = 0; n < 2; ++n) { const i32x4 gi = __builtin_bit_cast(i32x4, acc[ai][0][m][n]), ui = __builtin_bit_cast(i32x4, acc[ai][1][m][n]);
#pragma unroll
                for (int j = 0; j < 4; ++j) h[n][j] = fsilu((float)gi[j] * (sg[n][j] * r)) * ((float)ui[j] * (su[n][j] * r)); }
            *(u32x4*)(hid + (size_t)row * DFF + u.pn * 128 + wc * 32 + fq * 8) = pack8(h[0], h[1]); }
    }
};
struct EpiGate8 {
    static constexpr bool AFTER_DRAIN = false;
    bf16_t* gt; const float* cs; const float* rs;
    __device__ __forceinline__ void operator()(Acc& acc, const Unit& u, int wr, int wc, int fr, int fq) const {
        const int cb = u.pn * BM + wc * 32 + fq * 8;
        f32x4 sc[2][2];
#pragma unroll
        for (int bj = 0; bj < 2; ++bj)
#pragma unroll
            for (int n = 0; n < 2; ++n) sc[bj][n] = *(const f32x4*)(cs + cb + bj * HALF + 4 * n);
        EPI_ROWLOOP { const int row = u.pm * BM + ai * HALF + wr * 64 + m * 16 + fr; const float r = rs[row];
#pragma unroll
            for (int bj = 0; bj < 2; ++bj) { f32x4 v[2];
#pragma unroll
                for (int n = 0; n < 2; ++n) { const i32x4 zi = __builtin_bit_cast(i32x4, acc[ai][bj][m][n]);
#pragma unroll
                    for (int j = 0; j < 4; ++j) v[n][j] = fsigmoid((float)zi[j] * (sc[bj][n][j] * r)); }
                *(u32x4*)(gt + (size_t)row * 6144 + cb + bj * HALF) = pack8(v[0], v[1]); } }
    }
};
struct EpiDown {
    static constexpr bool AFTER_DRAIN = false;
    const float* res; float* out; float alpha; bf16_t* xn; const float* g; float* ssq;
    __device__ __forceinline__ void operator()(Acc& acc, const Unit& u, int wr, int wc, int fr, int fq) const {
        const int col0 = u.pn * BM + wc * 32 + fq * 8;
        EPI_ROWLOOP { const int row = u.pm * BM + ai * HALF + wr * 64 + m * 16 + fr; float ss = 0.f;
#pragma unroll
            for (int bj = 0; bj < 2; ++bj) { const size_t off = (size_t)row * DM + col0 + bj * HALF;
                const f32x4 r0 = *(const f32x4*)(res + off), r1 = *(const f32x4*)(res + off + 4);
                const f32x4 h0 = r0 + acc[ai][bj][m][0] * alpha, h1 = r1 + acc[ai][bj][m][1] * alpha;
                *(f32x4*)(out + off) = h0; *(f32x4*)(out + off + 4) = h1;
                ss += (h0[0] * h0[0] + h0[1] * h0[1]) + (h0[2] * h0[2] + h0[3] * h0[3]) + (h1[0] * h1[0] + h1[1] * h1[1]) + (h1[2] * h1[2] + h1[3] * h1[3]);
                if (xn) { const f32x4 g0 = *(const f32x4*)(g + col0 + bj * HALF), g1 = *(const f32x4*)(g + col0 + bj * HALF + 4); *(u32x4*)(xn + off) = pack8(h0 * g0, h1 * g1); } }
            ss += __shfl_xor(ss, 16); ss += __shfl_xor(ss, 32);
            if (fq == 0) atomicAdd(ssq + row, ss);
            asm volatile("" ::: "memory"); }
    }
};
struct EpiProj {
    static constexpr bool AFTER_DRAIN = false;
    unsigned char* ws; const float* ssq; const float* lb;
    __device__ __forceinline__ void operator()(Acc& acc, const Unit& u, int wr, int wc, int fr, int fq) const {
        const int grp = u.pn >> 2, cw = wc * 32 + fq * 8;
        EPI_ROWLOOP { const int row = u.pm * BM + ai * HALF + wr * 64 + m * 16 + fr; const float r = rsqrtf(ssq[row] * (1.0f / DM) + EPS);
#pragma unroll
            for (int bj = 0; bj < 2; ++bj) { f32x4 v0 = acc[ai][bj][m][0] * r, v1 = acc[ai][bj][m][1] * r;
                const int cc = (u.pn & 3) * 256 + bj * 128 + cw;
                if (grp < 3) {
                    bf16_t* T = (bf16_t*)(ws + WS_DQ + (size_t)grp * 16 * MiB); const int bl = row >> 12, t = row & 4095, g8 = cc >> 7;
                    *(u32x4*)(T + ((size_t)((bl * 8 + g8) * 4096 + t)) * 128 + (cc & 127)) = pack8(v0, v1);
                } else if (grp == 3) {
#pragma unroll
                    for (int j = 0; j < 4; ++j) { v0[j] = fsilu(v0[j]); v1[j] = fsilu(v1[j]); }
                    *(u32x4*)((bf16_t*)(ws + WS_HQ) + (size_t)row * 1024 + cc) = pack8(v0, v1);
                } else if (grp == 4) {
                    const f32x4 l0 = *(const f32x4*)(lb + cc), l1 = *(const f32x4*)(lb + cc + 4); f32x4 lf0, lf1, k0, k1;
#pragma unroll
                    for (int j = 0; j < 4; ++j) {
                        { const float z = fminf(fmaxf(v0[j], -30.f), 30.f), e = fexp(-z), sg = __builtin_amdgcn_rcpf(1.f + e), om = 1.f - l0[j]; lf0[j] = __logf(l0[j] + om * sg); k0[j] = om * e * sg; }
                        { const float z = fminf(fmaxf(v1[j], -30.f), 30.f), e = fexp(-z), sg = __builtin_amdgcn_rcpf(1.f + e), om = 1.f - l1[j]; lf1[j] = __logf(l1[j] + om * sg); k1[j] = om * e * sg; } }
                    float* LF = (float*)(ws + WS_HLF) + (size_t)row * 1024 + cc; *(f32x4*)LF = lf0; *(f32x4*)(LF + 4) = lf1;
                    *(u32x4*)((bf16_t*)(ws + WS_HK) + (size_t)row * 1024 + cc) = pack8(k0, k1);
                } else if (grp == 5) {
                    *(u32x4*)((bf16_t*)(ws + WS_HV) + (size_t)row * 1024 + cc) = pack8(v0, v1);
                } else if (grp == 6) {
#pragma unroll
                    for (int j = 0; j < 4; ++j) { v0[j] = fsigmoid(v0[j]); v1[j] = fsigmoid(v1[j]); }
                    *(u32x4*)((bf16_t*)(ws + WS_HG) + (size_t)row * 1024 + cc) = pack8(v0, v1);
                } else if (grp == 7) {
                    *(u32x4*)((bf16_t*)(ws + WS_XQ) + (size_t)row * 1024 + cc) = pack8(v0, v1);
                } else {
#pragma unroll
                    for (int j = 0; j < 4; ++j) { v0[j] = fsigmoid(v0[j]); v1[j] = fsigmoid(v1[j]); }
                    *(u32x4*)((bf16_t*)(ws + WS_GT) + (size_t)row * 6144 + (u.pn - 32) * 256 + bj * 128 + cw) = pack8(v0, v1);
                } } }
    }
};
struct EpiChain {
    static constexpr bool AFTER_DRAIN = false;
    const bf16_t* gt; bf16_t* out; float* pb;
    __device__ __forceinline__ void operator()(Acc& acc, const Unit& u, int wr, int wc, int fr, int fq) const {
        const int col0 = u.pn * BM + wc * 32 + fq * 8;
        if (u.sub > 0) { __builtin_amdgcn_fence(__ATOMIC_ACQUIRE, "agent"); }
        EPI_ROWLOOP { const int row = u.pm * BM + ai * HALF + wr * 64 + m * 16 + fr;
#pragma unroll
            for (int bj = 0; bj < 2; ++bj) { const bf16_t* gp = gt + (size_t)row * 6144 + u.sub * 2048 + col0 + bj * HALF; f32x4 a0, a1; unpack8(*(const u32x4*)gp, a0, a1);
                float* pp = pb + (size_t)row * DM + col0 + bj * HALF;
                f32x4 v0 = acc[ai][bj][m][0] * a0, v1 = acc[ai][bj][m][1] * a1;
                if (u.sub > 0) { v0 += *(const f32x4*)pp; v1 += *(const f32x4*)(pp + 4); }
                if (u.sub < 2) { *(f32x4*)pp = v0; *(f32x4*)(pp + 4) = v1; }
                else *(u32x4*)(out + (size_t)row * DM + col0 + bj * HALF) = pack8(v0, v1); }
            asm volatile("" ::: "memory"); }
    }
};
struct EpiStore {
    static constexpr bool AFTER_DRAIN = false;
    bf16_t* base; int ldc;
    __device__ __forceinline__ void operator()(Acc& acc, const Unit& u, int wr, int wc, int fr, int fq) const {
        EPI_ROWLOOP { const int r = ai * HALF + wr * 64 + m * 16 + fr;
#pragma unroll
            for (int bj = 0; bj < 2; ++bj) *(u32x4*)(base + (size_t)r * ldc + bj * HALF + wc * 32 + fq * 8) = pack8(acc[ai][bj][m][0], acc[ai][bj][m][1]); }
    }
};
struct EpiSoftmax {
    static constexpr bool AFTER_DRAIN = true;
    bf16_t* P; float scale;
    __device__ __forceinline__ void operator()(Acc&, const Unit&, int, int, int, int) const {}
    __device__ __forceinline__ void fused(Acc& acc, const Unit& u, int wr, int wc, int fr, int fq, LAS unsigned char* lds, int wid, int lane) const {
        LAS float* T1 = (LAS float*)lds; LAS float* T2 = (LAS float*)(lds + 4096);
        EPI_ROWLOOP { const int r = ai * HALF + wr * 64 + m * 16 + fr; float mx = -3.0e38f;
#pragma unroll
            for (int bj = 0; bj < 2; ++bj)
#pragma unroll
                for (int n = 0; n < 2; ++n)
#pragma unroll
                    for (int j = 0; j < 4; ++j) mx = fmaxf(mx, acc[ai][bj][m][n][j]);
            mx = fmaxf(mx, __shfl_xor(mx, 16)); mx = fmaxf(mx, __shfl_xor(mx, 32));
            if (fq == 0) T1[r * 4 + wc] = mx; }
        __syncthreads();
        const float c2 = scale * LOG2E;
        EPI_ROWLOOP { const int r = ai * HALF + wr * 64 + m * 16 + fr; const f32x4 mv = *(const LAS f32x4*)(T1 + r * 4); const float mx = fmaxf(fmaxf(mv[0], mv[1]), fmaxf(mv[2], mv[3])); float s = 0.f;
#pragma unroll
            for (int bj = 0; bj < 2; ++bj)
#pragma unroll
                for (int n = 0; n < 2; ++n)
#pragma unroll
                    for (int j = 0; j < 4; ++j) { const float e = __builtin_amdgcn_exp2f((acc[ai][bj][m][n][j] - mx) * c2); acc[ai][bj][m][n][j] = e; s += e; }
            s += __shfl_xor(s, 16); s += __shfl_xor(s, 32);
            if (fq == 0) T2[r * 4 + wc] = s; }
        __syncthreads();
        EPI_ROWLOOP { const int r = ai * HALF + wr * 64 + m * 16 + fr; const f32x4 sv = *(const LAS f32x4*)(T2 + r * 4); const float inv = __builtin_amdgcn_rcpf((sv[0] + sv[1]) + (sv[2] + sv[3]));
#pragma unroll
            for (int bj = 0; bj < 2; ++bj) *(u32x4*)(P + (size_t)r * 256 + bj * HALF + wc * 32 + fq * 8) = pack8(acc[ai][bj][m][0] * inv, acc[ai][bj][m][1] * inv); }
        __syncthreads();
    }
};
}

namespace att {
using bf16 = __hip_bfloat16;
constexpr int D = 128, NW = 8, QBLK = 32, KVBLK = 64, QB = NW * QBLK;
constexpr float SCALE = 0.08838834764831845f;
constexpr float THR = 8.f;
constexpr int SHM_V = KVBLK * D * 2, SHM_K = KVBLK * D * 2;
constexpr int LDS_BYTES = 2 * SHM_V + 2 * SHM_K + NW * 64 * 4;
#define KSWZ(row, colB) ((row) * 256 + ((colB) ^ (((row) & 7) << 4)))
#define SBAR() __builtin_amdgcn_sched_barrier(0)
__device__ __forceinline__ int v_st(int k, int c) { const int kk = (k & ~0xC) | ((k & 4) << 1) | ((k & 8) >> 1); return ((kk >> 3) * 4 + (c >> 5)) * 512 + ((kk & 7) * 32 + (c & 31)) * 2; }
__device__ __forceinline__ int v_rd_base(int lane) { return ((lane & 3) << 3) | (((lane >> 2) & 3) << 6) | (((lane >> 4) & 1) << 5) | (((lane >> 5) & 1) << 8); }
constexpr int v_rd_off(int d0, int ks, int half) { return d0 * 512 + ks * 4096 + half * 2048; }
__device__ __forceinline__ int crow(int r, int hi) { return (r & 3) + 8 * (r >> 2) + 4 * hi; }
__device__ __forceinline__ unsigned cvtpk(float lo, float hi) { return cvt_pk_bf16(lo, hi); }
__device__ __forceinline__ bf16x8 load8(const bf16* p) { return *reinterpret_cast<const bf16x8*>(p); }
__device__ __forceinline__ void mask_tile(f32x16& p0, f32x16& p1, int dq) {
    const float NEG = -__builtin_inff();
#pragma unroll
    for (int r = 0; r < 16; ++r) { const int c = (r & 3) + 8 * (r >> 2); if (dq - c < 0) p0[r] = NEG; if (dq - c - 32 < 0) p1[r] = NEG; }
}
__device__ __forceinline__ void partialSM(f32x16& p0, f32x16& p1, float& m_reg, float& mn, float& alpha) {
    float pmax = p0[0]; for (int r = 1; r < 16; ++r) pmax = fmaxf(pmax, p0[r]); for (int r = 0; r < 16; ++r) pmax = fmaxf(pmax, p1[r]);
    { auto rr = __builtin_amdgcn_permlane32_swap(__float_as_uint(pmax), __float_as_uint(pmax), false, false); pmax = fmaxf(__uint_as_float(rr[0]), __uint_as_float(rr[1])); }
    constexpr float C2 = 1.4426950408889634f * SCALE;
    if (__builtin_expect(__all((pmax - m_reg) * SCALE <= THR), 1)) { mn = m_reg; alpha = 1.f; }
    else { mn = fmaxf(m_reg, pmax); alpha = __builtin_amdgcn_exp2f((m_reg - mn) * C2); m_reg = mn; }
    const float mnL = -mn * C2;
    for (int r = 0; r < 16; ++r) p0[r] = fmaf(p0[r], C2, mnL); for (int r = 0; r < 16; ++r) p1[r] = fmaf(p1[r], C2, mnL);
    for (int r = 0; r < 16; ++r) p0[r] = __builtin_amdgcn_exp2f(p0[r]);
}
__device__ __forceinline__ void finishSM(f32x16& p0, f32x16& p1, float alpha, float& l_reg, bf16x8& pa0, bf16x8& pa1, bf16x8& pa2, bf16x8& pa3) {
    for (int r = 0; r < 16; ++r) p1[r] = __builtin_amdgcn_exp2f(p1[r]);
    float ps = 0; for (int r = 0; r < 16; ++r) ps += p0[r]; for (int r = 0; r < 16; ++r) ps += p1[r];
    { auto rr = __builtin_amdgcn_permlane32_swap(__float_as_uint(ps), __float_as_uint(ps), false, false); ps = __uint_as_float(rr[0]) + __uint_as_float(rr[1]); }
    l_reg = l_reg * alpha + ps;
#define PK4(P, B_, OUT) do { unsigned a0 = cvtpk(P[B_+0], P[B_+1]), a1 = cvtpk(P[B_+2], P[B_+3]); unsigned b0 = cvtpk(P[B_+4], P[B_+5]), b1 = cvtpk(P[B_+6], P[B_+7]); \
        auto r0 = __builtin_amdgcn_permlane32_swap(a0, b0, false, false); auto r1 = __builtin_amdgcn_permlane32_swap(a1, b1, false, false); \
        u32x4 w = {r0[0], r1[0], r0[1], r1[1]}; OUT = *reinterpret_cast<bf16x8*>(&w); } while (0)
    PK4(p0, 0, pa0); PK4(p0, 8, pa1); PK4(p1, 0, pa2); PK4(p1, 8, pa3);
#undef PK4
}
template <int KB>
__device__ __forceinline__ void qkt(f32x16& p0, f32x16& p1, const char* K_lds, int r32, int hi, const bf16x8* qr, float bb, float bs) {
    { const float bs2 = bs + bs, bs3 = bs2 + bs, bs8 = bs2 * 4.f, bs32 = bs8 * 4.f; float q = bb;
#pragma unroll
      for (int g = 0; g < 4; ++g) { p0[4 * g] = q; p0[4 * g + 1] = q + bs; p0[4 * g + 2] = q + bs2; p0[4 * g + 3] = q + bs3; q += bs8; }
#pragma unroll
      for (int r = 0; r < 16; ++r) p1[r] = p0[r] + bs32; }
    const char* kb[4];
#pragma unroll
    for (int dd = 0; dd < 4; ++dd) kb[dd] = K_lds + KB * SHM_K + KSWZ(r32, (dd * 16 + hi * 8) * 2);
#pragma unroll
    for (int d0 = 0; d0 < 8; ++d0) { const char* a = kb[d0 & 3] + (d0 >> 2) * 128;
        bf16x8 b0 = *reinterpret_cast<const bf16x8*>(a);
        bf16x8 b1 = *reinterpret_cast<const bf16x8*>(a + 32 * 256);
        p0 = __builtin_amdgcn_mfma_f32_32x32x16_bf16(b0, qr[d0], p0, 0, 0, 0);
        p1 = __builtin_amdgcn_mfma_f32_32x32x16_bf16(b1, qr[d0], p1, 0, 0, 0); }
}
template <int VB>
__device__ __forceinline__ void pv_tile(f32x16* o, int vb0, bf16x8 pa0, bf16x8 pa1, bf16x8 pa2, bf16x8 pa3) {
#define TRRD(dst, off) asm volatile("ds_read_b64_tr_b16 %0, %1 offset:%2" : "=&v"(dst) : "v"(vb0), "i"(off) : "memory")
#define PV_D0(d0) do { s16x4 l0, l1, l2, l3, h0, h1, h2, h3; constexpr int b_ = VB * SHM_V + v_rd_off(d0, 0, 0); \
        TRRD(l0, b_); TRRD(h0, b_ + 2048); TRRD(l1, b_ + 4096); TRRD(h1, b_ + 6144); TRRD(l2, b_ + 8192); TRRD(h2, b_ + 10240); TRRD(l3, b_ + 12288); TRRD(h3, b_ + 14336); \
        asm volatile("s_waitcnt lgkmcnt(0)" ::: "memory"); SBAR(); \
        o[d0] = __builtin_amdgcn_mfma_f32_32x32x16_bf16(pa0, (bf16x8){l0[0], l0[1], l0[2], l0[3], h0[0], h0[1], h0[2], h0[3]}, o[d0], 0, 0, 0); \
        o[d0] = __builtin_amdgcn_mfma_f32_32x32x16_bf16(pa1, (bf16x8){l1[0], l1[1], l1[2], l1[3], h1[0], h1[1], h1[2], h1[3]}, o[d0], 0, 0, 0); \
        o[d0] = __builtin_amdgcn_mfma_f32_32x32x16_bf16(pa2, (bf16x8){l2[0], l2[1], l2[2], l2[3], h2[0], h2[1], h2[2], h2[3]}, o[d0], 0, 0, 0); \
        o[d0] = __builtin_amdgcn_mfma_f32_32x32x16_bf16(pa3, (bf16x8){l3[0], l3[1], l3[2], l3[3], h3[0], h3[1], h3[2], h3[3]}, o[d0], 0, 0, 0); } while (0)
    PV_D0(0); PV_D0(1); PV_D0(2); PV_D0(3);
#undef PV_D0
#undef TRRD
}
struct BlockRef { const bf16* Q; const bf16* K; const bf16* V; bf16* O; int P0; float bs; };
#define VMW() asm volatile("s_waitcnt vmcnt(0)" ::: "memory")
#define SLOAD_H(Kp, Vp, k0) do { const char* kb_ = (const char*)(Kp) + (size_t)(k0) * (D * 2); const char* vb_ = (const char*)(Vp) + (size_t)(k0) * (D * 2); \
        st_v0 = *(const bf16x8*)(vb_ + slo); st_v1 = *(const bf16x8*)(vb_ + 32 * D * 2 + slo); st_k0 = *(const bf16x8*)(kb_ + slo); st_k1 = *(const bf16x8*)(kb_ + 32 * D * 2 + slo); } while (0)
#define SWRITE_H(bf) do { *(bf16x8*)(V_lds + (bf) * SHM_V + vst0) = st_v0; *(bf16x8*)(V_lds + (bf) * SHM_V + vst1) = st_v1; \
        *(bf16x8*)(K_lds + (bf) * SHM_K + kws) = st_k0; *(bf16x8*)(K_lds + (bf) * SHM_K + kws + 32 * 256) = st_k1; } while (0)
__device__ __forceinline__ void attn_block(const BlockRef& cur, char* lds) {
    int tid = threadIdx.x; asm volatile("" : "+v"(tid));
    const int wid = __builtin_amdgcn_readfirstlane(tid >> 6), lane = tid & 63, r32 = lane & 31, hi = lane >> 5;
    const int NT = cur.P0 / KVBLK + 4;
    const int qlo = cur.P0 + wid * QBLK, qm = qlo + r32 - 4 * hi;
    char* V_lds = lds; char* K_lds = lds + 2 * SHM_V;
    float* al_l = (float*)(lds + 2 * SHM_V + 2 * SHM_K) + wid * 64;
    float m_reg = -1e30f, l_reg = 0; f32x16 o[4] = {};
    const int sr = tid >> 4, sc = (tid & 15) * 8, vst0 = v_st(sr, sc), vst1 = v_st(32 + sr, sc), kws = KSWZ(sr, sc * 2);
    const int vb0 = (int)(uintptr_t)V_lds + v_rd_base(lane);
    const bf16* Kh = cur.K; const bf16* Vh = cur.V;
    const unsigned slo = (unsigned)((sr * D + sc) * 2), qlo_b = (unsigned)((r32 * D + hi * 8) * 2);
    const float bs = cur.bs, bb0 = bs * (float)(4 * hi - cur.P0);
    bf16x8 qr[8], st_v0, st_v1, st_k0, st_k1;
    { const char* qb_ = (const char*)cur.Q + (size_t)wid * (QBLK * D * 2);
#pragma unroll
      for (int d0 = 0; d0 < 8; ++d0) qr[d0] = *(const bf16x8*)(qb_ + qlo_b + d0 * 32); }
    SLOAD_H(Kh, Vh, 0); VMW(); SWRITE_H(0);
    __syncthreads();
    f32x16 p0, p1; float mn, al; bf16x8 pa0, pa1, pa2, pa3;
#define RESC(a) do { if (__any((a) < 1.f)) { if (hi == 0) al_l[r32] = (a); asm volatile("s_waitcnt lgkmcnt(0)" ::: "memory"); \
                     for (int d_ = 0; d_ < 4; ++d_) for (int r = 0; r < 16; ++r) o[d_][r] *= al_l[crow(r, hi)]; } } while (0)
#define STEP(t, BUF) do { const int kb_t = (t) * KVBLK; \
        if ((t) + 1 < NT) SLOAD_H(Kh, Vh, kb_t + KVBLK); \
        SBAR(); qkt<BUF>(p0, p1, K_lds, r32, hi, qr, fmaf(bs, (float)kb_t, bb0), bs); \
        if (kb_t + KVBLK - 1 > qlo) mask_tile(p0, p1, qm - kb_t); \
        partialSM(p0, p1, m_reg, mn, al); RESC(al); \
        finishSM(p0, p1, al, l_reg, pa0, pa1, pa2, pa3); SBAR(); \
        pv_tile<BUF>(o, vb0, pa0, pa1, pa2, pa3); \
        if ((t) + 1 < NT) { VMW(); SWRITE_H(1 - BUF); } \
        __syncthreads(); } while (0)
#pragma unroll 1
    for (int t = 0; t < NT; t += 2) { STEP(t, 0); STEP(t + 1, 1); }
#undef STEP
#undef RESC
    float* li_l = al_l;
    if (hi == 0) li_l[r32] = l_reg; asm volatile("s_waitcnt lgkmcnt(0)" ::: "memory");
    float rli[16];
#pragma unroll
    for (int r = 0; r < 16; ++r) rli[r] = __builtin_amdgcn_rcpf(li_l[crow(r, hi)]);
    char* Ow = (char*)cur.O + (size_t)wid * (QBLK * D * 2); const unsigned olo = (unsigned)((4 * hi * D + r32) * 2);
#pragma unroll
    for (int r = 0; r < 16; ++r) { const int orc = (r & 3) + 8 * (r >> 2);
#pragma unroll
        for (int d0 = 0; d0 < 4; ++d0) { const float v = o[d0][r] * rli[r]; const float vn = __shfl_xor(v, 1);
            if ((r32 & 1) == 0) *(unsigned*)(Ow + olo + orc * (D * 2) + d0 * 64) = cvtpk(v, vn); } }
    __syncthreads();
}
#undef VMW
#undef SLOAD_H
#undef SWRITE_H
}

struct Args {
    const float* in[26];
    float* out; unsigned char* ws;
};
enum { I_X = 0, I_MEM, I_F1N, I_F1G, I_F1U, I_F1D, I_MIXN, I_MEMNRM, I_WIN, I_LQ1, I_LK1, I_LQ2, I_LK2, I_SUBLN, I_LBL, I_HGN, I_WMKV, I_WBDA, I_WBHG, I_WBXA, I_WOUT, I_F2N, I_F2G, I_F2U, I_F2D, I_FINN };

__device__ __forceinline__ void transpose_item(const float* W, int ldw, int K, int N, bf16_t* WT, int row_off, int mode, LAS float* scr, int item, int lane) {
    const int nblk = N / 32, kb = item / nblk, nb = item % nblk, k0 = 64 * kb, n0 = 32 * nb;
#pragma unroll 8
    for (int i = 0; i < 32; ++i) { const int kk = 2 * i + (lane >> 5); scr[kk * 33 + (lane & 31)] = W[(size_t)(k0 + kk) * ldw + n0 + (lane & 31)]; }
    asm volatile("s_waitcnt lgkmcnt(0)" ::: "memory");
    const int c = lane & 7;
    const int d0 = mode == 0 ? row_off + n0 : ((n0 >> 7) * 256 + (n0 & 127) + (mode == 2 ? 128 : 0));
#pragma unroll
    for (int j = 0; j < 4; ++j) { const int n = (lane >> 3) + 8 * j; const LAS float* s = scr + (8 * c) * 33 + n;
        u32x4 o; o.x = cvt_pk_bf16(s[0 * 33], s[1 * 33]); o.y = cvt_pk_bf16(s[2 * 33], s[3 * 33]); o.z = cvt_pk_bf16(s[4 * 33], s[5 * 33]); o.w = cvt_pk_bf16(s[6 * 33], s[7 * 33]);
        *(u32x4*)(WT + (size_t)(d0 + n) * K + k0 + 8 * c) = o; }
    asm volatile("s_waitcnt lgkmcnt(0)" ::: "memory");
}
__device__ __forceinline__ void run_transpose(const float* W, int K, int N, bf16_t* WT, int row_off, int mode, LAS float* scr, int gw, int ngw, int lane, int ldw = 0) {
    if (ldw == 0) ldw = N;
    const int items = (K / 64) * (N / 32);
    for (int it = gw; it < items; it += ngw) transpose_item(W, ldw, K, N, WT, row_off, mode, scr, it, lane);
}

__device__ __forceinline__ unsigned q8(float v) { return (unsigned)((int)rintf(fminf(fmaxf(v, -127.f), 127.f))) & 0xffu; }
__device__ __forceinline__ unsigned q8x4(float a, float b, float c, float d) { return q8(a) | (q8(b) << 8) | (q8(c) << 16) | (q8(d) << 24); }
__device__ __forceinline__ void absmax_item(const float* W, int ldw, int N, unsigned* cmax, int mode, int up, int item, int lane) {
    const int nblk = N / 32, kb = item / nblk, nb = item % nblk, k0 = 64 * kb, n0 = 32 * nb; float mx = 0.f;
#pragma unroll 8
    for (int i = 0; i < 32; ++i) { const int kk = 2 * i + (lane >> 5); mx = fmaxf(mx, fabsf(W[(size_t)(k0 + kk) * ldw + n0 + (lane & 31)])); }
    mx = fmaxf(mx, __shfl_xor(mx, 32));
    if (lane < 32) atomicMax(cmax + (mode ? (n0 >> 7) * 256 + (n0 & 127) + up * 128 : n0) + lane, __float_as_uint(mx));
}
__device__ __forceinline__ void quant_item(const float* W, int ldw, int K, int N, unsigned char* W8, const unsigned* cmax, float* cs, int mode, int up, LAS float* scr, int item, int lane) {
    const int nblk = N / 32, kb = item / nblk, nb = item % nblk, k0 = 64 * kb, n0 = 32 * nb;
#pragma unroll 8
    for (int i = 0; i < 32; ++i) { const int kk = 2 * i + (lane >> 5); scr[kk * 33 + (lane & 31)] = W[(size_t)(k0 + kk) * ldw + n0 + (lane & 31)]; }
    asm volatile("s_waitcnt lgkmcnt(0)" ::: "memory");
    const int n = lane >> 1, hf = lane & 1, row = (mode ? (n0 >> 7) * 256 + (n0 & 127) + up * 128 : n0) + n;
    const float cm = fmaxf(__uint_as_float(cmax[row]), 1e-30f), sc = 127.0f / cm;
    const LAS float* sp = scr + (32 * hf) * 33 + n; unsigned w[8];
#pragma unroll
    for (int t = 0; t < 8; ++t) w[t] = q8x4(sp[(4 * t) * 33] * sc, sp[(4 * t + 1) * 33] * sc, sp[(4 * t + 2) * 33] * sc, sp[(4 * t + 3) * 33] * sc);
    unsigned char* dp = W8 + (size_t)row * K + k0 + 32 * hf;
    *(u32x4*)dp = (u32x4){w[0], w[1], w[2], w[3]}; *(u32x4*)(dp + 16) = (u32x4){w[4], w[5], w[6], w[7]};
    if (kb == 0 && hf == 0) cs[row] = cm * (1.0f / 127.0f);
    asm volatile("s_waitcnt lgkmcnt(0)" ::: "memory");
}
__device__ __forceinline__ f32x4 mfma16(bf16x8 a, bf16x8 b, f32x4 c) {
    f32x4 d = __builtin_amdgcn_mfma_f32_16x16x32_bf16(a, b, c, 0, 0, 0);
    asm volatile("" :: "v"(a), "v"(b));
    return d;
}
constexpr int BSTR = 132;
constexpr int HL_B = 0, HL_TOT = 64 * BSTR * 4, HL_Q1 = HL_TOT + 2048, HL_K1 = HL_Q1 + 17408, HL_Q2 = HL_K1 + 17408, HL_VT = HL_Q2 + 17408, HL_ST = HL_VT + 18432, HL_P = HL_ST + 34816, HL_RS = HL_P + 9216, HL_END = HL_RS + 512;
static_assert(HL_END <= LDS_BYTES, "hgrn lds");
constexpr int LDQ = 136, LDT = 72;
template <bool PASS_C>
__device__ __forceinline__ void hgrn_unit(unsigned char* lds, unsigned char* ws, const float* hg_norm, int bh, int c) {
    int tid = threadIdx.x; asm volatile("" : "+v"(tid));
    const int lane = tid & 63, wid = tid >> 6, fr = lane & 15, fq = lane >> 4;
    const int bl = bh >> 3, h = bh & 7; const size_t r0 = (size_t)bl * 4096 + (size_t)c * 64;
    float* bF = (float*)(lds + HL_B); float* tot = (float*)(lds + HL_TOT);
    bf16_t* Q1 = (bf16_t*)(lds + HL_Q1); bf16_t* K1 = (bf16_t*)(lds + HL_K1); bf16_t* Q2 = (bf16_t*)(lds + HL_Q2); bf16_t* VT = (bf16_t*)(lds + HL_VT);
    bf16_t* ST = (bf16_t*)(lds + HL_ST); bf16_t* Pm = (bf16_t*)(lds + HL_P); float* RS = (float*)(lds + HL_RS);
    const float* LF = (const float*)(ws + WS_HLF); const bf16_t* HQ = (const bf16_t*)(ws + WS_HQ); const bf16_t* HK = (const bf16_t*)(ws + WS_HK); const bf16_t* HV = (const bf16_t*)(ws + WS_HV);
    bf16_t* LS = (bf16_t*)(ws + WS_HGS) + ((size_t)(bh * 64 + c)) * 16384;
#pragma unroll
    for (int i = 0; i < 4; ++i) { const int e = tid + 512 * i, s = e >> 5, k4 = (e & 31) * 4; *(f32x4*)(bF + s * BSTR + k4) = *(const f32x4*)(LF + (r0 + s) * 1024 + h * 128 + k4); }
    u32x4 qv[2], kv[2];
#pragma unroll
    for (int i = 0; i < 2; ++i) { const int e = tid + 512 * i;
        { const int s = PASS_C ? (e >> 4) : (e & 63), k8 = PASS_C ? ((e & 15) * 8) : ((e >> 6) * 8); const size_t go = (r0 + s) * 1024 + h * 128 + k8;
          if (PASS_C) qv[i] = *(const u32x4*)(HQ + go);
          kv[i] = *(const u32x4*)(HK + go); }
        { const int s = e & 63, k8 = (e >> 6) * 8; const u32x4 vv = *(const u32x4*)(HV + (r0 + s) * 1024 + h * 128 + k8); const unsigned w[4] = {vv.x, vv.y, vv.z, vv.w};
#pragma unroll
          for (int j = 0; j < 4; ++j) { VT[(k8 + 2 * j) * LDT + s] = (bf16_t)(w[j] & 0xffffu); VT[(k8 + 2 * j + 1) * LDT + s] = (bf16_t)(w[j] >> 16); } } }
    if (PASS_C) {
#pragma unroll
        for (int i = 0; i < 4; ++i) { const int e = tid + 512 * i, v = e >> 4, k8 = (e & 15) * 8; u32x4 w_ = TESTZEROST ? (u32x4){0u, 0u, 0u, 0u} : *(const u32x4*)(LS + v * 128 + k8);
#if TESTSANST
            { unsigned ww[4] = {w_.x, w_.y, w_.z, w_.w};
#pragma unroll
              for (int j = 0; j < 4; ++j) { if ((ww[j] & 0x7f80u) > 0x4d00u) ww[j] &= 0xffff0000u; if ((ww[j] & 0x7f800000u) > 0x4d000000u) ww[j] &= 0x0000ffffu; }
              w_ = (u32x4){ww[0], ww[1], ww[2], ww[3]}; }
#endif
            *(u32x4*)(ST + v * LDQ + k8) = w_; } }
    __syncthreads();
    { const int k = tid & 127, seg = tid >> 7; float run = 0.f;
#pragma unroll
        for (int s = 0; s < 16; ++s) { run += bF[(seg * 16 + s) * BSTR + k]; bF[(seg * 16 + s) * BSTR + k] = run; }
        tot[seg * 128 + k] = run; }
    __syncthreads();
    { const int k = tid & 127, seg = tid >> 7; float pre = 0.f;
        for (int g = 0; g < seg; ++g) pre += tot[g * 128 + k];
        if (seg > 0) {
#pragma unroll
            for (int s = 0; s < 16; ++s) bF[(seg * 16 + s) * BSTR + k] += pre; } }
    __syncthreads();
#pragma unroll
    for (int i = 0; i < 2; ++i) { const int e = tid + 512 * i, s = PASS_C ? (e >> 4) : (e & 63), k8 = PASS_C ? ((e & 15) * 8) : ((e >> 6) * 8);
        f32x4 k0, k1; unpack8(kv[i], k0, k1);
        const f32x4 b0 = *(const f32x4*)(bF + s * BSTR + k8), b1 = *(const f32x4*)(bF + s * BSTR + k8 + 4);
        if (PASS_C) {
            f32x4 q0, q1; unpack8(qv[i], q0, q1);
            const f32x4 m0 = *(const f32x4*)(bF + 31 * BSTR + k8), m1 = *(const f32x4*)(bF + 31 * BSTR + k8 + 4);
            f32x4 a0, a1, c0, c1, d0, d1;
#pragma unroll
            for (int j = 0; j < 4; ++j) { a0[j] = q0[j] * fexp(b0[j] - m0[j]); a1[j] = q1[j] * fexp(b1[j] - m1[j]); c0[j] = k0[j] * fexp(m0[j] - b0[j]); c1[j] = k1[j] * fexp(m1[j] - b1[j]);
                d0[j] = q0[j] * fexp(b0[j]); d1[j] = q1[j] * fexp(b1[j]); }
            *(u32x4*)(Q1 + s * LDQ + k8) = pack8(a0, a1); *(u32x4*)(K1 + s * LDQ + k8) = pack8(c0, c1); *(u32x4*)(Q2 + s * LDQ + k8) = pack8(d0, d1);
        } else {
            const f32x4 e0 = *(const f32x4*)(bF + 63 * BSTR + k8), e1 = *(const f32x4*)(bF + 63 * BSTR + k8 + 4);
            bf16_t* KT = Q1;
#pragma unroll
            for (int j = 0; j < 4; ++j) { const unsigned w0 = cvt_pk_bf16(k0[j] * fexp(e0[j] - b0[j]), 0.f), w1 = cvt_pk_bf16(k1[j] * fexp(e1[j] - b1[j]), 0.f);
                KT[(k8 + j) * LDT + s] = (bf16_t)(w0 & 0xffffu); KT[(k8 + 4 + j) * LDT + s] = (bf16_t)(w1 & 0xffffu); }
        } }
    if (!PASS_C) { if (tid < 128) ((float*)(ws + WS_HGD))[(size_t)(bh * 64 + c) * 128 + tid] = fexp(bF[63 * BSTR + tid]); }
    __syncthreads();
    if (!PASS_C) {
        const bf16_t* KT = Q1;
        const bf16x8 a0 = *(const bf16x8*)(KT + (16 * wid + fr) * LDT + 8 * fq), a1 = *(const bf16x8*)(KT + (16 * wid + fr) * LDT + 32 + 8 * fq);
#pragma unroll
        for (int tv = 0; tv < 8; ++tv) { f32x4 acc = {0.f, 0.f, 0.f, 0.f};
            const bf16x8 b0 = *(const bf16x8*)(VT + (16 * tv + fr) * LDT + 8 * fq), b1 = *(const bf16x8*)(VT + (16 * tv + fr) * LDT + 32 + 8 * fq);
            acc = mfma16(a0, b0, acc); acc = mfma16(a1, b1, acc);
            u32x2 o; o.x = cvt_pk_bf16(acc[0], acc[1]); o.y = cvt_pk_bf16(acc[2], acc[3]);
#if TESTCONSTL
            o.x = 0x3c003c00u; o.y = 0x3c003c00u;
#endif
            *(u32x2*)(LS + (size_t)(16 * tv + fr) * 128 + 16 * wid + 4 * fq) = o; }
    } else {
#pragma unroll
        for (int q = 0; q < 2; ++q) { const int tile = wid + 8 * q, tt = tile >> 2, ts = tile & 3; f32x4 acc = {0.f, 0.f, 0.f, 0.f};
            if (ts <= tt) {
#pragma unroll
                for (int ks = 0; ks < 4; ++ks) { const bf16x8 a = *(const bf16x8*)(K1 + (16 * ts + fr) * LDQ + 32 * ks + 8 * fq), b = *(const bf16x8*)(Q1 + (16 * tt + fr) * LDQ + 32 * ks + 8 * fq);
                    acc = mfma16(a, b, acc); } }
            const int t = 16 * tt + fr, s0 = 16 * ts + 4 * fq;
#pragma unroll
            for (int i = 0; i < 4; ++i) if (s0 + i > t) acc[i] = 0.f;
            u32x2 o; o.x = cvt_pk_bf16(acc[0], acc[1]); o.y = cvt_pk_bf16(acc[2], acc[3]);
            *(u32x2*)(Pm + t * LDT + s0) = o; }
        __syncthreads();
        const int tt = wid & 3, vh = wid >> 2; f32x4 oacc[4]; float ss = 0.f;
        const bf16x8 p0 = *(const bf16x8*)(Pm + (16 * tt + fr) * LDT + 8 * fq), p1 = *(const bf16x8*)(Pm + (16 * tt + fr) * LDT + 32 + 8 * fq);
        bf16x8 q2[4];
#pragma unroll
        for (int ks = 0; ks < 4; ++ks) q2[ks] = *(const bf16x8*)(Q2 + (16 * tt + fr) * LDQ + 32 * ks + 8 * fq);
#pragma unroll
        for (int j = 0; j < 4; ++j) { const int tv = 4 * vh + j; f32x4 acc = {0.f, 0.f, 0.f, 0.f};
            acc = mfma16(*(const bf16x8*)(VT + (16 * tv + fr) * LDT + 8 * fq), p0, acc);
            acc = mfma16(*(const bf16x8*)(VT + (16 * tv + fr) * LDT + 32 + 8 * fq), p1, acc);
#if !TESTNOSTATE
#pragma unroll
            for (int ks = 0; ks < 4; ++ks) acc = mfma16(*(const bf16x8*)(ST + (16 * tv + fr) * LDQ + 32 * ks + 8 * fq), q2[ks], acc);
#endif
            oacc[j] = acc; ss += (acc[0] * acc[0] + acc[1] * acc[1]) + (acc[2] * acc[2] + acc[3] * acc[3]); }
        ss += __shfl_xor(ss, 16); ss += __shfl_xor(ss, 32);
        if (fq == 0) RS[(16 * tt + fr) * 2 + vh] = ss;
        __syncthreads();
        const float rinv = rsqrtf((RS[(16 * tt + fr) * 2] + RS[(16 * tt + fr) * 2 + 1]) * (1.0f / 128.f) + EPS);
        const size_t row = r0 + 16 * tt + fr; const bf16_t* HGp = (const bf16_t*)(ws + WS_HG); bf16_t* Y = (bf16_t*)(ws + WS_HQ);
#pragma unroll
        for (int j = 0; j < 4; ++j) { const int col = h * 128 + 16 * (4 * vh + j) + 4 * fq; const f32x4 gn = *(const f32x4*)(hg_norm + col); const u32x2 gw = *(const u32x2*)(HGp + row * 1024 + col);
            const float y0 = oacc[j][0] * rinv * gn[0] * bf_lo(gw.x), y1 = oacc[j][1] * rinv * gn[1] * bf_hi(gw.x), y2 = oacc[j][2] * rinv * gn[2] * bf_lo(gw.y), y3 = oacc[j][3] * rinv * gn[3] * bf_hi(gw.y);
            u32x2 o; o.x = cvt_pk_bf16(y0, y1); o.y = cvt_pk_bf16(y2, y3); *(u32x2*)(Y + row * 1024 + col) = o; }
    }
    __syncthreads();
}

#define XB_TMO      128
#define XB_XCNT(j)  (256  + 64 * (j))
#define XB_XSUB(j)  (1280 + 64 * (j))
#define XB_XGEN(j)  (2304 + 64 * (j))
#define XB_TOP      3328
#define XB_TOPGEN   3392
#define XCD_BAR_WORDS 3456
#define XB_SPIN_CAP (1u << 20)
__device__ __forceinline__ unsigned xb_ld(unsigned* p)              { return __hip_atomic_load(p, __ATOMIC_RELAXED, __HIP_MEMORY_SCOPE_AGENT); }
__device__ __forceinline__ unsigned xb_add(unsigned* p, unsigned v) { return __hip_atomic_fetch_add(p, v, __ATOMIC_RELAXED, __HIP_MEMORY_SCOPE_AGENT); }
__device__ __forceinline__ unsigned xb_xcc_id() { return (unsigned)__builtin_amdgcn_s_getreg((3 << 11) | 20) & 0xFu; }
#define XB_SPIN(cond, bar) do { unsigned _sp = 0; while (cond) { __builtin_amdgcn_s_sleep(1); \
    if ((++_sp & 255u) == 0u) { if (xb_ld(&(bar)[XB_TMO])) break; if (_sp > XB_SPIN_CAP) { atomicAdd(&(bar)[XB_TMO], 1u); break; } } } } while (0)
struct XcdBarrier { unsigned* bar; unsigned x; volatile LAS unsigned* st; };
__device__ __forceinline__ XcdBarrier xcd_barrier_post(unsigned* bar, volatile LAS unsigned* st) {
    XcdBarrier b; b.bar = bar; b.x = xb_xcc_id(); b.st = st;
    if (threadIdx.x == 0) (void)xb_add(&bar[XB_XCNT(b.x)], 1u);
    return b;
}
__device__ __forceinline__ void xcd_barrier_complete(unsigned* bar, unsigned x, unsigned& nloc, unsigned& nx) {
    const unsigned G = gridDim.x * gridDim.y * gridDim.z;
    unsigned sum, cnt, mine, sp = 0u;
    for (;;) {
        sum = 0u; cnt = 0u; mine = 0u;
#pragma unroll
        for (unsigned j = 0; j < 16; ++j) { const unsigned c = xb_ld(&bar[XB_XCNT(j)]); sum += c; cnt += (c > 0u) ? 1u : 0u; mine = (j == x) ? c : mine; }
        if (sum == G) break;
        __builtin_amdgcn_s_sleep(1);
        if ((++sp & 255u) == 0u) { if (xb_ld(&bar[XB_TMO])) break; if (sp > XB_SPIN_CAP) { atomicAdd(&bar[XB_TMO], 1u); break; } }
    }
    nloc = mine > 0u ? mine : 1u; nx = cnt > 0u ? cnt : 1u;
}
__device__ __forceinline__ void xcd_barrier(const XcdBarrier& b) {
    asm volatile("s_waitcnt vmcnt(0) lgkmcnt(0)" ::: "memory");
    __syncthreads();
    if (threadIdx.x == 0) {
        unsigned* bar = b.bar;
        __builtin_amdgcn_s_waitcnt(0);
        unsigned nloc = b.st[0], nx = b.st[1];
        if (nloc == 0u) { xcd_barrier_complete(bar, b.x, nloc, nx); b.st[0] = nloc; b.st[1] = nx; }
        const unsigned old = xb_add(&bar[XB_XSUB(b.x)], 1u);
        const unsigned gen = old / nloc;
        if (old + 1u == (gen + 1u) * nloc) {
            __builtin_amdgcn_fence(__ATOMIC_RELEASE, "agent");
            asm volatile("s_waitcnt vmcnt(0)" ::: "memory");
            const unsigned og = xb_add(&bar[XB_TOP], 1u);
            const unsigned tg = og / nx;
            if (og + 1u == (tg + 1u) * nx) xb_add(&bar[XB_TOPGEN], 1u);
            else XB_SPIN(xb_ld(&bar[XB_TOPGEN]) == tg, bar);
            __builtin_amdgcn_fence(__ATOMIC_ACQUIRE, "agent");
            xb_add(&bar[XB_XGEN(b.x)], 1u);
            asm volatile("s_waitcnt vmcnt(0)" ::: "memory");
        } else {
            XB_SPIN(xb_ld(&bar[XB_XGEN(b.x)]) == gen, bar);
            __builtin_amdgcn_fence(__ATOMIC_ACQUIRE, "agent");
            asm volatile("s_waitcnt vmcnt(0)" ::: "memory");
        }
    }
    __syncthreads();
}

#ifdef ONLY
#define PH(n) ((n) == ONLY)
#else
#define PH(n) 1
#endif
__global__ void __launch_bounds__(512) fwd_megakernel(Args args) {
    extern __shared__ __attribute__((aligned(16))) unsigned char lds[];
    cg::grid_group grid = cg::this_grid();
    LAS unsigned char* ldsL = (LAS unsigned char*)lds;
    unsigned char* ws = args.ws;
    const int G = gridDim.x, bx = blockIdx.x, NGW = G * 8;
    { volatile LAS unsigned* st0 = (volatile LAS unsigned*)(ldsL + LDS_MISC); if (threadIdx.x < 4) st0[threadIdx.x] = 0u; }
    __syncthreads();
    const XcdBarrier xbar = xcd_barrier_post((unsigned*)(args.ws + WS_CTL), (volatile LAS unsigned*)(ldsL + LDS_MISC));
#define GRID_SYNC() xcd_barrier(xbar)
#define IDS() int tid = threadIdx.x; asm volatile("" : "+v"(tid)); const int lane = tid & 63, wave = __builtin_amdgcn_readfirstlane(tid >> 6), gw = bx * 8 + wave; (void)lane; (void)gw
    float* ssq = (float*)(ws + WS_SSQ);
    float* lbp = (float*)(ws + WS_LB);
    float* out = args.out;
    bf16_t* XA = (bf16_t*)(ws + WS_XA); bf16_t* XB = (bf16_t*)(ws + WS_XB); bf16_t* HID = (bf16_t*)(ws + WS_HID);
    bf16_t* WGU = (bf16_t*)(ws + WS_WGU); bf16_t* WD = (bf16_t*)(ws + WS_WD); bf16_t* WIN = (bf16_t*)(ws + WS_WIN); bf16_t* WMK = (bf16_t*)(ws + WS_WMK);
    bf16_t* WBR = (bf16_t*)(ws + WS_WBR); bf16_t* WO = (bf16_t*)(ws + WS_WO); bf16_t* MEMN = (bf16_t*)(ws + WS_MEMN);

    {
        IDS(); LAS float* scr = (LAS float*)(ldsL + wave * 16384);
        { unsigned* cm1 = (unsigned*)(ws + WS_CMAX1); const int items = (DM / 64) * (DFF / 32);
          for (int it = gw; it < items; it += NGW) { absmax_item(args.in[I_F1G], DFF, DFF, cm1, 1, 0, it, lane); absmax_item(args.in[I_F1U], DFF, DFF, cm1, 1, 1, it, lane); }
          unsigned* cmg = (unsigned*)(ws + WS_CMAXG); const int itg = (DM / 64) * (6144 / 32);
          for (int it = gw; it < itg; it += NGW) absmax_item(args.in[I_WIN] + 8192, INCOLS, 6144, cmg, 0, 0, it, lane); }
        run_transpose(args.in[I_F1D], DFF, DM, WD, 0, 0, scr, gw, NGW, lane);
        run_transpose(args.in[I_WIN], DM, 8192, WIN, 0, 0, scr, gw, NGW, lane, INCOLS);
        run_transpose(args.in[I_WMKV], DM, 2048, WMK, 0, 0, scr, gw, NGW, lane);
        run_transpose(args.in[I_WBDA], 1024, DM, WBR, 0, 0, scr, gw, NGW, lane);
        run_transpose(args.in[I_WBHG], 1024, DM, WBR, 2048, 0, scr, gw, NGW, lane);
        run_transpose(args.in[I_WBXA], 1024, DM, WBR, 4096, 0, scr, gw, NGW, lane);
        run_transpose(args.in[I_WOUT], DM, DM, WO, 0, 0, scr, gw, NGW, lane);
        const float* x = args.in[I_X]; const float* g1 = args.in[I_F1N]; unsigned char* XA8 = (unsigned char*)XA;
        for (int m = gw; m < MTOK; m += NGW) { const f32x4* xr = (const f32x4*)(x + (size_t)m * DM); f32x4 a[4], b[4]; float s = 0.f;
#pragma unroll
            for (int j = 0; j < 4; ++j) { const int c8 = lane + 64 * j; a[j] = xr[2 * c8]; b[j] = xr[2 * c8 + 1];
                s += (a[j][0] * a[j][0] + a[j][1] * a[j][1]) + (a[j][2] * a[j][2] + a[j][3] * a[j][3]) + (b[j][0] * b[j][0] + b[j][1] * b[j][1]) + (b[j][2] * b[j][2] + b[j][3] * b[j][3]); }
            s = wave_sum(s); float am = 0.f;
#pragma unroll
            for (int j = 0; j < 4; ++j) { const int c8 = lane + 64 * j; const f32x4 ga = *(const f32x4*)(g1 + 8 * c8), gb = *(const f32x4*)(g1 + 8 * c8 + 4); a[j] = a[j] * ga; b[j] = b[j] * gb;
#pragma unroll
                for (int q = 0; q < 4; ++q) am = fmaxf(am, fmaxf(fabsf(a[j][q]), fabsf(b[j][q]))); }
#pragma unroll
            for (int o = 1; o < 64; o <<= 1) am = fmaxf(am, __shfl_xor(am, o));
            am = fmaxf(am, 1e-30f); const float r = 127.0f / am;
#pragma unroll
            for (int j = 0; j < 4; ++j) { const int c8 = lane + 64 * j;
                u32x2 o; o.x = q8x4(a[j][0] * r, a[j][1] * r, a[j][2] * r, a[j][3] * r); o.y = q8x4(b[j][0] * r, b[j][1] * r, b[j][2] * r, b[j][3] * r);
                *(u32x2*)(XA8 + (size_t)m * DM + 8 * c8) = o; }
            if (lane == 0) { ssq[m] = am * (1.0f / 127.0f) * rsqrtf(s * (1.0f / DM) + EPS); ssq[MTOK + m] = 0.f; ssq[2 * MTOK + m] = 0.f; ssq[3 * MTOK + m] = 0.f; } }
        const float* mem = args.in[I_MEM]; const float* gm = args.in[I_MEMNRM];
        for (int m = gw; m < NB * MEMLEN; m += NGW) { const f32x4* xr = (const f32x4*)(mem + (size_t)m * DM); f32x4 a[4], b[4]; float s = 0.f;
#pragma unroll
            for (int j = 0; j < 4; ++j) { const int c8 = lane + 64 * j; a[j] = xr[2 * c8]; b[j] = xr[2 * c8 + 1];
                s += (a[j][0] * a[j][0] + a[j][1] * a[j][1]) + (a[j][2] * a[j][2] + a[j][3] * a[j][3]) + (b[j][0] * b[j][0] + b[j][1] * b[j][1]) + (b[j][2] * b[j][2] + b[j][3] * b[j][3]); }
            const float r = rsqrtf(wave_sum(s) * (1.0f / DM) + EPS);
#pragma unroll
            for (int j = 0; j < 4; ++j) { const int c8 = lane + 64 * j; const f32x4 ga = *(const f32x4*)(gm + 8 * c8), gb = *(const f32x4*)(gm + 8 * c8 + 4);
                *(u32x4*)(MEMN + (size_t)m * DM + 8 * c8) = pack8(a[j] * ga * r, b[j] * gb * r); } }
        if (bx == 0) { const float* lbl = args.in[I_LBL];
            for (int j = tid; j < 1024; j += 512) lbp[j] = 1.0f / (1.0f + expf(lbl[1024 + j] - lbl[j]));
            if (wave == 0) { const float* q1 = args.in[I_LQ1]; const float* k1 = args.in[I_LK1]; const float* q2 = args.in[I_LQ2]; const float* k2 = args.in[I_LK2];
                float s1 = q1[lane] * k1[lane] + q1[lane + 64] * k1[lane + 64], s2 = q2[lane] * k2[lane] + q2[lane + 64] * k2[lane + 64];
                s1 = wave_sum(s1); s2 = wave_sum(s2); if (lane == 0) *(float*)(ws + WS_LAM) = expf(s1) - expf(s2) + 0.2f; } }
    }
    GRID_SYNC();
    { IDS(); LAS float* scr = (LAS float*)(ldsL + wave * 16384); const unsigned* cm1 = (const unsigned*)(ws + WS_CMAX1); float* cs1 = (float*)(ws + WS_CS1); const int items = (DM / 64) * (DFF / 32);
      for (int it = gw; it < items; it += NGW) { quant_item(args.in[I_F1G], DFF, DM, DFF, (unsigned char*)WGU, cm1, cs1, 1, 0, scr, it, lane); quant_item(args.in[I_F1U], DFF, DM, DFF, (unsigned char*)WGU, cm1, cs1, 1, 1, scr, it, lane); }
      const int itg = (DM / 64) * (6144 / 32);
      for (int it = gw; it < itg; it += NGW) quant_item(args.in[I_WIN] + 8192, INCOLS, DM, 6144, (unsigned char*)(WIN + (size_t)8192 * DM), (const unsigned*)(ws + WS_CMAXG), (float*)(ws + WS_CSG), 0, 0, scr, it, lane); }
    GRID_SYNC();
    if (args.out == nullptr) grid.sync();

    {
        pg8::StdOrder S; S.T.init(MTOK / 256, 2 * DFF / 256, G, bx); S.A = (const char*)XA; S.B = (const char*)WGU; S.a_t = (size_t)256 * DM; S.b_t = (size_t)256 * DM;
        pg8::EpiUp8 E{HID, (const float*)(ws + WS_CS1), ssq};
        if (PH(10)) pg8::gemm_phase<pg8::EpiUp8, pg8::StdOrder, true, true>(ldsL, DM / 2, DM / 2, DM / 2, S, E);
        pg8::OneUnit O; O.have = bx < 32; pg8::EpiStore ES{nullptr, 256};
        if (bx < 16) { const int pm = bx >> 2, pn = bx & 3; O.u0 = pg8::Unit{(const char*)(MEMN + (size_t)pm * 256 * DM), (const char*)(WMK + (size_t)pn * 256 * DM), pm, pn, 0, 0}; ES.base = (bf16_t*)(ws + WS_KMEM) + (size_t)(pm * 4 + pn) * 65536; }
        else if (bx < 32) { const int q = bx - 16, pm = q >> 2, pn = q & 3; O.u0 = pg8::Unit{(const char*)(WMK + (size_t)(1024 + pm * 256) * DM), (const char*)(MEMN + (size_t)pn * 256 * DM), pm, pn, 0, 0}; ES.base = (bf16_t*)(ws + WS_VTM) + (size_t)(pn * 4 + pm) * 65536; }
        else O.u0 = pg8::Unit{nullptr, nullptr, 0, 0, 0, 0};
        if (PH(11)) pg8::gemm_phase<pg8::EpiStore, pg8::OneUnit, false>(ldsL, DM, DM, DM, O, ES);
    }
    GRID_SYNC();
    {
        pg8::StdOrder S; S.T.init(MTOK / 256, DM / 256, G, bx); S.A = (const char*)HID; S.B = (const char*)WD; S.a_t = (size_t)256 * DFF * 2; S.b_t = (size_t)256 * DFF * 2;
        pg8::EpiDown E{args.in[I_X], out, 0.5f, XA, args.in[I_MIXN], ssq + MTOK};
        if (PH(12)) pg8::gemm_phase<pg8::EpiDown, pg8::StdOrder, true>(ldsL, DFF, DFF, DFF, S, E);
    }
    GRID_SYNC();
    {
        IDS(); unsigned char* X8 = (unsigned char*)(ws + WS_XA8G);
        for (int m = gw; m < MTOK; m += NGW) { f32x4 a[4], b[4]; float am = 0.f;
#pragma unroll
            for (int j = 0; j < 4; ++j) { const int c8 = lane + 64 * j; unpack8(*(const u32x4*)(XA + (size_t)m * DM + 8 * c8), a[j], b[j]);
#pragma unroll
                for (int q = 0; q < 4; ++q) am = fmaxf(am, fmaxf(fabsf(a[j][q]), fabsf(b[j][q]))); }
#pragma unroll
            for (int o = 1; o < 64; o <<= 1) am = fmaxf(am, __shfl_xor(am, o));
            am = fmaxf(am, 1e-30f); const float r = 127.0f / am;
#pragma unroll
            for (int j = 0; j < 4; ++j) { const int c8 = lane + 64 * j;
                u32x2 o; o.x = q8x4(a[j][0] * r, a[j][1] * r, a[j][2] * r, a[j][3] * r); o.y = q8x4(b[j][0] * r, b[j][1] * r, b[j][2] * r, b[j][3] * r);
                *(u32x2*)(X8 + (size_t)m * DM + 8 * c8) = o; }
            if (lane == 0) ssq[m] = am * (1.0f / 127.0f) * rsqrtf(ssq[MTOK + m] * (1.0f / DM) + EPS); }
    }
    GRID_SYNC();

#if TESTMODE == 1
    { IDS(); LAS float* scr = (LAS float*)(ldsL + wave * 16384);
      run_transpose(args.in[I_F2G], DM, DFF, WGU, 0, 1, scr, gw, NGW, lane); run_transpose(args.in[I_F2U], DM, DFF, WGU, 0, 2, scr, gw, NGW, lane); run_transpose(args.in[I_F2D], DFF, DM, WD, 0, 0, scr, gw, NGW, lane); }
    GRID_SYNC();
#else
    for (int half = 0; half < 2; ++half) {
        const size_t hrow = (size_t)half * HROWS;
        {
            pg8::StdOrder S; S.T.init(HROWS / 256, 8192 / 256, G, bx); S.A = (const char*)(XA + hrow * DM); S.B = (const char*)WIN; S.a_t = (size_t)256 * DM * 2; S.b_t = (size_t)256 * DM * 2;
            pg8::EpiProj E{ws, ssq + MTOK + hrow, lbp};
            if (PH(13)) pg8::gemm_phase<pg8::EpiProj, pg8::StdOrder, true>(ldsL, DM, DM, DM, S, E);
            pg8::StdOrder S8; S8.T.init(HROWS / 256, 6144 / 256, G, bx); S8.A = (const char*)(ws + WS_XA8G) + hrow * DM; S8.B = (const char*)(WIN + (size_t)8192 * DM); S8.a_t = (size_t)256 * DM; S8.b_t = (size_t)256 * DM;
            pg8::EpiGate8 E8{(bf16_t*)(ws + WS_GT), (const float*)(ws + WS_CSG), ssq + hrow};
            pg8::gemm_phase<pg8::EpiGate8, pg8::StdOrder, true, true>(ldsL, DM / 2, DM / 2, DM / 2, S8, E8);
        }
        GRID_SYNC();
        {
            using att::bf16;
#if PH(1) && !(TESTSKIP & 1)
            for (int L = bx; L < 256; L += G) {
                const int xcd = L & 7, k = L >> 3, bl = xcd >> 2, h = xcd & 3, c = k >> 4, vh = (k >> 3) & 1, pr = k & 7;
                const bf16* Qb = (const bf16*)(ws + WS_DQ) + (size_t)((bl * 8 + h * 2 + c) * 4096) * 128;
                const bf16* Kb = (const bf16*)(ws + WS_DK) + (size_t)((bl * 8 + h * 2 + c) * 4096) * 128;
                const bf16* Vb = (const bf16*)(ws + WS_DV) + (size_t)((bl * 8 + h * 2 + vh) * 4096) * 128;
                bf16* Ob = (bf16*)(ws + WS_OB) + (size_t)((((bl * 4 + h) * 2 + c) * 2 + vh) * 4096) * 128;
                const float slope = exp2f(-2.0f * (float)(h + 1)), bsl = slope / att::SCALE;
#pragma unroll 1
                for (int pass = 0; pass < 2; ++pass) { const int qb = pass ? 15 - pr : pr;
                    att::BlockRef cur{Qb + (size_t)qb * 256 * 128, Kb, Vb, Ob + (size_t)qb * 256 * 128, qb * 256, bsl};
                    att::attn_block(cur, (char*)lds); }
            }
#endif
            asm volatile("s_waitcnt vmcnt(0)" ::: "memory");
            __syncthreads();
#if !(TESTSKIP & 2)
            for (int it = bx; it < 128; it += G) {
                const int tl = it >> 2, h = it & 3, bgl = half * 2 + (tl >> 4);
                bf16_t* XQ = (bf16_t*)(ws + WS_XQ) + (size_t)tl * 256 * 1024 + h * 256;
                bf16_t* Ps = (bf16_t*)(ws + WS_PSCR) + (size_t)bx * 65536;
                pg8::OneUnit O; O.have = true;
                O.u0 = pg8::Unit{(const char*)XQ, (const char*)((bf16_t*)(ws + WS_KMEM) + (size_t)(bgl * 4 + h) * 65536), 0, 0, 0, 0};
                pg8::EpiSoftmax E1{Ps, 0.0625f};
                if (PH(14)) pg8::gemm_phase<pg8::EpiSoftmax, pg8::OneUnit, false>(ldsL, 256, 1024, 256, O, E1);
                asm volatile("s_waitcnt vmcnt(0)" ::: "memory");
                __threadfence(); __syncthreads();
                O.u0 = pg8::Unit{(const char*)Ps, (const char*)((bf16_t*)(ws + WS_VTM) + (size_t)(bgl * 4 + h) * 65536), 0, 0, 0, 0};
                pg8::EpiStore E2{XQ, 1024};
                if (PH(15)) pg8::gemm_phase<pg8::EpiStore, pg8::OneUnit, false>(ldsL, 256, 256, 256, O, E2);
                asm volatile("s_waitcnt vmcnt(0)" ::: "memory");
                __syncthreads();
            }
#endif
#if PH(2) && !(TESTSKIP & 4)
            if (G == 256) {
                const int nu = bx < 128 ? 3 : 5, u0 = bx < 128 ? bx : 384 + (bx - 128);
                for (int j = 0; j < nu; ++j) { const int u = u0 + 128 * j; hgrn_unit<false>(lds, ws, args.in[I_HGN], u >> 6, u & 63); }
            } else
            for (int u = bx; u < 1024; u += G) hgrn_unit<false>(lds, ws, args.in[I_HGN], u >> 6, u & 63);
#endif
        }
        GRID_SYNC();
        {
            IDS(); LAS float* scr = (LAS float*)(ldsL + wave * 16384);
            const float lam = *(const float*)(ws + WS_LAM); const float* subln = args.in[I_SUBLN];
            const bf16_t* OB = (const bf16_t*)(ws + WS_OB); bf16_t* YDA = (bf16_t*)(ws + WS_DQ);
            const f32x4 sg = *(const f32x4*)(subln + 4 * lane);
#if !(TESTSKIP & 8)
            for (int p = gw; p < HROWS * 4; p += NGW) { const int r = p >> 2, h = p & 3, bl = r >> 12, t = r & 4095, vh = lane >> 5, ee = (4 * lane) & 127;
                const size_t o0 = ((size_t)((((bl * 4 + h) * 2 + 0) * 2 + vh) * 4096 + t)) * 128 + ee, o1 = ((size_t)((((bl * 4 + h) * 2 + 1) * 2 + vh) * 4096 + t)) * 128 + ee;
                const u32x2 a = *(const u32x2*)(OB + o0), b = *(const u32x2*)(OB + o1);
                f32x4 d; d[0] = bf_lo(a.x) - lam * bf_lo(b.x); d[1] = bf_hi(a.x) - lam * bf_hi(b.x); d[2] = bf_lo(a.y) - lam * bf_lo(b.y); d[3] = bf_hi(a.y) - lam * bf_hi(b.y);
                const float ssum = wave_sum((d[0] * d[0] + d[1] * d[1]) + (d[2] * d[2] + d[3] * d[3])); const float rr = rsqrtf(ssum * (1.0f / 256.f) + EPS) * 0.8f;
                u32x2 o; o.x = cvt_pk_bf16(d[0] * rr * sg[0], d[1] * rr * sg[1]); o.y = cvt_pk_bf16(d[2] * rr * sg[2], d[3] * rr * sg[3]);
                *(u32x2*)(YDA + (size_t)r * 1024 + h * 256 + 4 * lane) = o; }
#endif
#if !(TESTSKIP & 16)
            bf16_t* LSb = (bf16_t*)(ws + WS_HGS); const float* HGD = (const float*)(ws + WS_HGD);
            for (int e = bx * 512 + tid; e < 16 * 4096; e += G * 512) { const int bh = e >> 12, v = (e >> 5) & 127, k4 = (e & 31) * 4; f32x4 st = {0.f, 0.f, 0.f, 0.f};
                bf16_t* p = LSb + (size_t)bh * 64 * 16384 + v * 128 + k4; const float* dp = HGD + (size_t)bh * 64 * 128 + k4;
#pragma unroll 4
                for (int c = 0; c < 64; ++c) { const u32x2 lw = *(const u32x2*)(p + (size_t)c * 16384); const f32x4 dk = *(const f32x4*)(dp + c * 128);
                    u32x2 o; o.x = cvt_pk_bf16(st[0], st[1]); o.y = cvt_pk_bf16(st[2], st[3]); *(u32x2*)(p + (size_t)c * 16384) = o;
                    st[0] = dk[0] * st[0] + bf_lo(lw.x); st[1] = dk[1] * st[1] + bf_hi(lw.x); st[2] = dk[2] * st[2] + bf_lo(lw.y); st[3] = dk[3] * st[3] + bf_hi(lw.y); } }
#endif
            { unsigned* cm2 = (unsigned*)(ws + WS_CMAX2); const int items = (DM / 64) * (DFF / 32);
              if (half == 0) {
                  for (int it = gw; it < items; it += NGW) { absmax_item(args.in[I_F2G], DFF, DFF, cm2, 1, 0, it, lane); absmax_item(args.in[I_F2U], DFF, DFF, cm2, 1, 1, it, lane); }
              } else {
                  float* cs2 = (float*)(ws + WS_CS2);
                  for (int it = gw; it < items; it += NGW) { quant_item(args.in[I_F2G], DFF, DM, DFF, (unsigned char*)WGU, cm2, cs2, 1, 0, scr, it, lane); quant_item(args.in[I_F2U], DFF, DM, DFF, (unsigned char*)WGU, cm2, cs2, 1, 1, scr, it, lane); }
                  run_transpose(args.in[I_F2D], DFF, DM, WD, 0, 0, scr, gw, NGW, lane);
              } }
        }
        GRID_SYNC();
#if PH(3) && !(TESTSKIP & 32)
        for (int u = bx; u < 1024; u += G) hgrn_unit<true>(lds, ws, args.in[I_HGN], u >> 6, u & 63);
#endif
        GRID_SYNC();
        {
            pg8::ChainOrder S; S.T.init(HROWS / 256, DM / 256, G, bx);
            static_assert(WS_HQ - WS_DQ == 48 * MiB && WS_XQ - WS_DQ == 144 * MiB, "branch inputs: triangular spacing");
            S.A = (const char*)(ws + WS_DQ); S.a_sub = 48 * MiB; S.B = (const char*)WBR; S.b_sub = (size_t)2048 * 1024 * 2;
            S.a_t = (size_t)256 * 1024 * 2; S.b_t = (size_t)256 * 1024 * 2;
            pg8::EpiChain E{(const bf16_t*)(ws + WS_GT), XA + hrow * DM, (float*)(ws + WS_OB)};
#if !(TESTSKIP & 64)
            if (PH(16)) pg8::gemm_phase<pg8::EpiChain, pg8::ChainOrder, true>(ldsL, 1024, 1024, 1024, S, E);
#endif
        }
        GRID_SYNC();
    }
    {
        pg8::StdOrder S; S.T.init(MTOK / 256, DM / 256, G, bx); S.A = (const char*)XA; S.B = (const char*)WO;
#if TESTSKIP & 128
        S.A = (const char*)(ws + WS_DQ);
#endif
        S.a_t = (size_t)256 * DM * 2; S.b_t = (size_t)256 * DM * 2;
        pg8::EpiDown E{out, out, 1.0f, XB, args.in[I_F2N], ssq + 2 * MTOK};
        if (PH(17)) pg8::gemm_phase<pg8::EpiDown, pg8::StdOrder, true>(ldsL, DM, DM, DM, S, E);
    }
    GRID_SYNC();
#endif
    {
        IDS(); unsigned char* XA8 = (unsigned char*)XA;
        for (int m = gw; m < MTOK; m += NGW) { f32x4 a[4], b[4]; float am = 0.f;
#pragma unroll
            for (int j = 0; j < 4; ++j) { const int c8 = lane + 64 * j; unpack8(*(const u32x4*)(XB + (size_t)m * DM + 8 * c8), a[j], b[j]);
#pragma unroll
                for (int q = 0; q < 4; ++q) am = fmaxf(am, fmaxf(fabsf(a[j][q]), fabsf(b[j][q]))); }
#pragma unroll
            for (int o = 1; o < 64; o <<= 1) am = fmaxf(am, __shfl_xor(am, o));
            am = fmaxf(am, 1e-30f); const float r = 127.0f / am;
#pragma unroll
            for (int j = 0; j < 4; ++j) { const int c8 = lane + 64 * j;
                u32x2 o; o.x = q8x4(a[j][0] * r, a[j][1] * r, a[j][2] * r, a[j][3] * r); o.y = q8x4(b[j][0] * r, b[j][1] * r, b[j][2] * r, b[j][3] * r);
                *(u32x2*)(XA8 + (size_t)m * DM + 8 * c8) = o; }
            if (lane == 0) ssq[m] = am * (1.0f / 127.0f) * rsqrtf(ssq[2 * MTOK + m] * (1.0f / DM) + EPS); }
    }
    GRID_SYNC();
    {
        pg8::StdOrder S; S.T.init(MTOK / 256, 2 * DFF / 256, G, bx); S.A = (const char*)XA; S.B = (const char*)WGU; S.a_t = (size_t)256 * DM; S.b_t = (size_t)256 * DM;
        pg8::EpiUp8 E{HID, (const float*)(ws + WS_CS2), ssq};
        if (PH(18)) pg8::gemm_phase<pg8::EpiUp8, pg8::StdOrder, true, true>(ldsL, DM / 2, DM / 2, DM / 2, S, E);
    }
    GRID_SYNC();
    {
        pg8::StdOrder S; S.T.init(MTOK / 256, DM / 256, G, bx); S.A = (const char*)HID; S.B = (const char*)WD; S.a_t = (size_t)256 * DFF * 2; S.b_t = (size_t)256 * DFF * 2;
        pg8::EpiDown E{out, out, 0.5f, nullptr, nullptr, ssq + 3 * MTOK};
        if (PH(19)) pg8::gemm_phase<pg8::EpiDown, pg8::StdOrder, true>(ldsL, DFF, DFF, DFF, S, E);
    }
    GRID_SYNC();
    {
        IDS();
        const float* gf = args.in[I_FINN];
        for (int m = gw; m < MTOK; m += NGW) { const float r = rsqrtf(ssq[3 * MTOK + m] * (1.0f / DM) + EPS); f32x4* xr = (f32x4*)(out + (size_t)m * DM);
#pragma unroll
            for (int j = 0; j < 8; ++j) { const int c4 = lane + 64 * j; f32x4 v = xr[c4] * r * *(const f32x4*)(gf + 4 * c4);
#if TESTSANITIZE
                for (int q = 0; q < 4; ++q) if (!(fabsf(v[q]) < 1e30f)) v[q] = 100.f;
#endif
                xr[c4] = v; } }
    }
}

extern "C" void kernel_launch(void* const* d_in, const int* in_sizes, int n_in, void* d_out, int out_size, void* d_ws, size_t ws_size, hipStream_t stream) {
    static int grid = 0;
    if (grid == 0) {
        if (n_in != 26 || in_sizes[0] != MTOK * DM || out_size != MTOK * DM || ws_size < WS_END) { fprintf(stderr, "kernel_launch: unexpected shapes (n_in %d, in0 %d, out %d, ws %zu < %zu)\n", n_in, n_in > 0 ? in_sizes[0] : -1, out_size, ws_size, (size_t)WS_END); grid = -1; return; }
        int dev = 0, cus = 0, per_cu = 0;
        (void)hipGetDevice(&dev); (void)hipDeviceGetAttribute(&cus, hipDeviceAttributeMultiprocessorCount, dev);
        if (hipFuncSetAttribute((const void*)fwd_megakernel, hipFuncAttributeMaxDynamicSharedMemorySize, LDS_BYTES) != hipSuccess) { fprintf(stderr, "kernel_launch: hipFuncSetAttribute failed\n"); grid = -1; return; }
        if (hipOccupancyMaxActiveBlocksPerMultiprocessor(&per_cu, (const void*)fwd_megakernel, 512, LDS_BYTES) != hipSuccess || per_cu < 1) { fprintf(stderr, "kernel_launch: occupancy query says %d\n", per_cu); per_cu = 1; }
        (void)hipGetLastError();
        grid = cus > 0 ? cus : 256;
    }
    if (grid < 0) return;
    if (hipMemsetAsync((char*)d_ws + WS_CTL, 0, CTL_BYTES, stream) != hipSuccess) { fprintf(stderr, "kernel_launch: memset of barrier words failed\n"); return; }
    Args a{};
    for (int i = 0; i < 26; ++i) a.in[i] = (const float*)d_in[i];
    a.out = (float*)d_out; a.ws = (unsigned char*)d_ws;
    void* kargs[] = {&a};
    hipError_t e = hipLaunchCooperativeKernel((const void*)fwd_megakernel, dim3(grid), dim3(512), kargs, LDS_BYTES, stream);
    if (e != hipSuccess) fprintf(stderr, "cooperative launch failed: %s (grid %d)\n", hipGetErrorString(e), grid);
}
```

```cpp
#include <hip/hip_runtime.h>
#include <hip/hip_bf16.h>
#include <hip/hip_cooperative_groups.h>
#include <cstdio>
#include <cstdint>
namespace cg = cooperative_groups;

#define LAS __attribute__((address_space(3)))
typedef unsigned short bf16_t;
typedef short bf16x8 __attribute__((ext_vector_type(8)));
typedef short s16x4 __attribute__((ext_vector_type(4)));
typedef float f32x4 __attribute__((ext_vector_type(4)));
typedef float f32x16 __attribute__((ext_vector_type(16)));
typedef unsigned u32x4 __attribute__((ext_vector_type(4)));
typedef unsigned u32x2 __attribute__((ext_vector_type(2)));
typedef int i32x4 __attribute__((ext_vector_type(4)));

constexpr int DM = 2048, NB = 4, SEQ = 4096, MTOK = NB * SEQ, MEMLEN = 256, DFF = 5632, INCOLS = 14336;
constexpr int HROWS = MTOK / 2;
constexpr float EPS = 1e-6f;
constexpr float LOG2E = 1.4426950408889634f;

constexpr size_t MiB = 1u << 20;
constexpr size_t WS_SSQ = 0;
constexpr size_t WS_LB = 256 * 1024, WS_LAM = 260 * 1024;
constexpr size_t WS_HGD = 512 * 1024;
constexpr size_t WS_CTL = 1 * MiB, CTL_BYTES = 192 * 1024;
constexpr size_t WS_CMAX1 = WS_CTL + 16384, WS_CMAX2 = WS_CTL + 65536, WS_CMAXG = WS_CTL + 112 * 1024, WS_CS1 = WS_CTL + 192 * 1024, WS_CS2 = WS_CTL + 240 * 1024, WS_CSG = WS_CTL + 288 * 1024;
constexpr size_t WS_XA8G = 48 * MiB;
constexpr size_t WS_MEMN = 2 * MiB, WS_KMEM = 6 * MiB, WS_VTM = 8 * MiB;
constexpr size_t WS_WGU = 16 * MiB, WS_WD = 60 * MiB;
constexpr size_t WS_PSCR = 16 * MiB;
constexpr size_t WS_WIN = 82 * MiB, WS_WMK = 138 * MiB, WS_WBR = 146 * MiB, WS_WO = 158 * MiB;
constexpr size_t WS_XA = 166 * MiB;
constexpr size_t WS_BIG = 230 * MiB;
constexpr size_t WS_DQ = WS_BIG, WS_DK = WS_BIG + 16 * MiB, WS_DV = WS_BIG + 32 * MiB, WS_HQ = WS_BIG + 48 * MiB, WS_HK = WS_BIG + 64 * MiB,
                 WS_HV = WS_BIG + 80 * MiB, WS_HG = WS_BIG + 96 * MiB, WS_HLF = WS_BIG + 112 * MiB, WS_XQ = WS_BIG + 144 * MiB, WS_GT = WS_BIG + 160 * MiB;
constexpr size_t WS_OB = 486 * MiB, WS_HGS = 518 * MiB, WS_END = 550 * MiB;
constexpr size_t WS_HID = WS_BIG, WS_XB = WS_BIG + 176 * MiB;
static_assert(WS_XB + 64 * MiB <= WS_END, "ws map");

constexpr int LDS_BYTES = 160 * 1024;
constexpr int LDS_MISC = LDS_BYTES - 64;
#define TESTMODE 0
#define TESTSKIP 0
#define TESTCONSTL 0
#define TESTNOSTATE 0
#define TESTZEROST 0
#define TESTSANST 0
#define TESTSANITIZE 0
#define TESTCHAIN 0

typedef float f32x2_t __attribute__((ext_vector_type(2)));
typedef __bf16 bf16x2_t __attribute__((ext_vector_type(2)));
__device__ __forceinline__ unsigned cvt_pk_bf16(float lo, float hi) { f32x2_t v = {lo, hi}; bf16x2_t b = __builtin_convertvector(v, bf16x2_t); return __builtin_bit_cast(unsigned, b); }
__device__ __forceinline__ float bf_lo(unsigned w) { return __uint_as_float(w << 16); }
__device__ __forceinline__ float bf_hi(unsigned w) { return __uint_as_float(w & 0xffff0000u); }
__device__ __forceinline__ float fexp(float x) { return __builtin_amdgcn_exp2f(x * LOG2E); }
__device__ __forceinline__ float fsigmoid(float x) { return __builtin_amdgcn_rcpf(1.0f + fexp(-x)); }
__device__ __forceinline__ float fsilu(float x) { return x * fsigmoid(x); }
__device__ __forceinline__ u32x4 pack8(f32x4 a, f32x4 b) { u32x4 w; w.x = cvt_pk_bf16(a[0], a[1]); w.y = cvt_pk_bf16(a[2], a[3]); w.z = cvt_pk_bf16(b[0], b[1]); w.w = cvt_pk_bf16(b[2], b[3]); return w; }
__device__ __forceinline__ void unpack8(u32x4 w, f32x4& a, f32x4& b) { a = (f32x4){bf_lo(w.x), bf_hi(w.x), bf_lo(w.y), bf_hi(w.y)}; b = (f32x4){bf_lo(w.z), bf_hi(w.z), bf_lo(w.w), bf_hi(w.w)}; }
__device__ __forceinline__ float wave_sum(float v) {
#pragma unroll
    for (int o = 1; o < 64; o <<= 1) v += __shfl_xor(v, o);
    return v;
}

namespace pg8 {
constexpr int BM = 256, BK = 64, HALF = 128, HTB = HALF * BK * 2, STAGE_BYTES = 8 * HTB, NXCD = 8, WGM = 8;
__host__ __device__ __forceinline__ int lds_byte(int r, int c) { const int st = (r >> 4) * 2 + (c >> 5), rr = r & 15, cc = c & 31, ob = rr * 64 + cc * 2; return st * 1024 + (ob ^ (((ob >> 9) & 1) << 5)); }
__host__ __device__ __forceinline__ void stage_rc(int b, int& R, int& C) { const int st = b / 1024, sb = b % 1024, swz = sb ^ (((sb >> 9) & 1) << 5); R = (st >> 1) * 16 + swz / 64; C = (st & 1) * 32 + (swz % 64) / 2; }
__host__ __device__ __forceinline__ int perm32(int rho) { const int n = rho >> 4, i = rho & 15; return 8 * (i >> 2) + 4 * n + (i & 3); }

struct Unit { const char* A; const char* B; int pm, pn, sub, keep; };

struct TileOrder {
    int nM, nN, nwg, G, c;
    __device__ void init(int nM_, int nN_, int G_, int c_) { nM = nM_; nN = nN_; nwg = nM * nN; G = G_; c = c_; }
    __device__ bool tile(long L, int& pm, int& pn) const {
        if (L >= nwg) return false;
        int wgid = (int)L; { const int q = nwg / NXCD, r = nwg % NXCD, xcd = wgid % NXCD, off = wgid / NXCD; wgid = (xcd < r ? xcd * (q + 1) : r * (q + 1) + (xcd - r) * q) + off; }
        const int nig = WGM * nN, gid = wgid / nig, fm = gid * WGM, gsz = (nM - fm) < WGM ? (nM - fm) : WGM;
        pm = fm + ((wgid % nig) % gsz); pn = (wgid % nig) / gsz; return true;
    }
};
struct StdOrder {
    TileOrder T; const char* A; const char* B; size_t a_t, b_t;
    __device__ bool next(int i, Unit& u) const { int pm, pn; if (!T.tile((long)i * T.G + T.c, pm, pn)) return false; u.pm = pm; u.pn = pn; u.sub = 0; u.keep = 0; u.A = A + (size_t)pm * a_t; u.B = B + (size_t)pn * b_t; return true; }
};
struct ChainOrder {
    TileOrder T; const char* A; const char* B; size_t a_sub, b_sub, a_t, b_t;
    __device__ bool next(int i, Unit& u) const {
#if TESTCHAIN >= 1
        const int ti = i, sub = (TESTCHAIN == 1) ? 2 : (TESTCHAIN - 2);
#else
        const int ti = i / 3, sub = i - 3 * ti;
#endif
        int pm, pn; if (!T.tile((long)ti * T.G + T.c, pm, pn)) return false; u.pm = pm; u.pn = pn; u.sub = sub; u.keep = 0;
        u.A = A + a_sub * (size_t)((sub * (sub + 1)) >> 1) + (size_t)pm * a_t; u.B = B + b_sub * (size_t)sub + (size_t)pn * b_t; return true; }
};
struct OneUnit {
    Unit u0; bool have;
    __device__ bool next(int i, Unit& u) const { if (i != 0 || !have) return false; u = u0; return true; }
};

template <class Epi, class Sched, bool ALIGN_EPI, bool I8 = false>
__device__ __forceinline__ void gemm_phase(LAS unsigned char* lds, const int K, const int lda, const int ldb, const Sched& S, const Epi& E) {
    int tid = threadIdx.x; asm volatile("" : "+v"(tid));
    const int wid = __builtin_amdgcn_readfirstlane(tid >> 6), lane = tid & 63, wr = wid >> 2, wc = wid & 3, fr = lane & 15, fq = lane >> 4;
    int nt = K / BK; asm volatile("" : "+s"(nt));
    unsigned voffA[2], voffB[2];
#pragma unroll
    for (int i = 0; i < 2; ++i) { int R, C; stage_rc(tid * 16 + i * 8192, R, C); const int Rb = (R & ~31) + perm32(R & 31);
        voffA[i] = (unsigned)(R * lda + C) * 2u; voffB[i] = (unsigned)(Rb * ldb + C) * 2u; }
    const size_t kstep = (size_t)(BK * 2);
    const size_t hstepA = (size_t)HALF * lda * 2, hstepB = (size_t)HALF * ldb * 2;
    const unsigned ldsw = (unsigned)wid * 1024u;
    const int aoff = lds_byte(wr * 64 + fr, fq * 8), boff = lds_byte(wc * 32 + fr, fq * 8);
#define PG8_SA(b, h) (((b) * 2 + (h)) * HTB)
#define PG8_SB(b, h) ((4 + (b) * 2 + (h)) * HTB)
#define PG8_STAGE(bufoff, gbase, voff) do { _Pragma("unroll") for (int _i = 0; _i < 2; ++_i) \
        __builtin_amdgcn_global_load_lds((const unsigned*)((const char*)(gbase) + (voff)[_i]), (LAS unsigned*)(lds + (bufoff) + ldsw + _i * 8192), 16, 0, 0); } while (0)
#define PG8_LDA(dst, b, h) do { _Pragma("unroll") for (int m = 0; m < 4; ++m) _Pragma("unroll") for (int k = 0; k < 2; ++k) dst[m][k] = *(const LAS bf16x8*)(lds + PG8_SA(b, h) + aoff + m * 2048 + k * 1024); } while (0)
#define PG8_LDB(dst, b, h) do { _Pragma("unroll") for (int n = 0; n < 2; ++n) _Pragma("unroll") for (int k = 0; k < 2; ++k) dst[n][k] = *(const LAS bf16x8*)(lds + PG8_SB(b, h) + boff + n * 2048 + k * 1024); } while (0)
#define PG8_MMA(ai, bj, At, Bt) do { __builtin_amdgcn_s_setprio(1); _Pragma("unroll") for (int m = 0; m < 4; ++m) _Pragma("unroll") for (int n = 0; n < 2; ++n) _Pragma("unroll") for (int k = 0; k < 2; ++k) \
        { if constexpr (I8) acc[ai][bj][m][n] = __builtin_bit_cast(f32x4, __builtin_amdgcn_mfma_i32_16x16x64_i8(__builtin_bit_cast(i32x4, Bt[n][k]), __builtin_bit_cast(i32x4, At[m][k]), __builtin_bit_cast(i32x4, acc[ai][bj][m][n]), 0, 0, 0)); \
          else acc[ai][bj][m][n] = __builtin_amdgcn_mfma_f32_16x16x32_bf16(Bt[n][k], At[m][k], acc[ai][bj][m][n], 0, 0, 0); } __builtin_amdgcn_s_setprio(0); } while (0)
#define PG8_WAIT_V(n) asm volatile("s_waitcnt vmcnt(" #n ")" ::: "memory")
#define PG8_WAIT_L(n) asm volatile("s_waitcnt lgkmcnt(" #n ")" ::: "memory")
#define PG8_BAR __builtin_amdgcn_s_barrier()
#define PG8_SCHED __builtin_amdgcn_sched_barrier(0)
    Unit cur, nxt; int ui = 0;
    if (!S.next(0, cur)) return;
    f32x4 acc[2][2][4][2];
#pragma unroll
    for (int a = 0; a < 2; ++a)
#pragma unroll
        for (int b = 0; b < 2; ++b)
#pragma unroll
            for (int m = 0; m < 4; ++m)
#pragma unroll
                for (int n = 0; n < 2; ++n) acc[a][b][m][n] = (f32x4){0.f, 0.f, 0.f, 0.f};
    bf16x8 At[4][2], B0[2][2], B1[2][2];
    const char* cA = cur.A; const char* cB = cur.B;
    PG8_STAGE(PG8_SB(0, 0), cB, voffB); PG8_STAGE(PG8_SB(0, 1), cB + hstepB, voffB); PG8_STAGE(PG8_SA(0, 0), cA, voffA); PG8_STAGE(PG8_SA(0, 1), cA + hstepA, voffA);
    if (wr == 1) PG8_BAR;
    PG8_WAIT_V(2); PG8_BAR;
    PG8_STAGE(PG8_SB(1, 0), cB + kstep, voffB); PG8_STAGE(PG8_SA(1, 0), cA + kstep, voffA); PG8_STAGE(PG8_SB(1, 1), cB + hstepB + kstep, voffB);
    PG8_WAIT_V(6); PG8_BAR;
    for (;;) {
        const bool has_next = S.next(ui + 1, nxt);
        const char* nA = has_next ? nxt.A : cA; const char* nB = has_next ? nxt.B : cB;
#pragma unroll 1
        for (int t = 0; t < nt; t += 2) {
            const bool last = (t == nt - 2);
            const char* a1 = cA + (size_t)(t + 1) * kstep;
            const char* a2 = last ? nA : cA + (size_t)(t + 2) * kstep; const char* b2 = last ? nB : cB + (size_t)(t + 2) * kstep;
            const char* a3 = a2 + kstep; const char* b3 = b2 + kstep;
            PG8_LDB(B0, 0, 0); PG8_LDB(B1, 0, 1); PG8_SCHED; PG8_LDA(At, 0, 0); PG8_STAGE(PG8_SA(1, 1), a1 + hstepA, voffA);
            PG8_WAIT_V(8); PG8_WAIT_L(0); PG8_BAR; PG8_MMA(0, 0, At, B0); PG8_MMA(0, 1, At, B1); PG8_BAR; PG8_SCHED;
            PG8_LDA(At, 0, 1); PG8_STAGE(PG8_SB(0, 0), b2, voffB); PG8_STAGE(PG8_SB(0, 1), b2 + hstepB, voffB); PG8_STAGE(PG8_SA(0, 0), a2, voffA);
            PG8_WAIT_V(8); PG8_WAIT_L(0); PG8_BAR; PG8_MMA(1, 0, At, B0); PG8_MMA(1, 1, At, B1); PG8_BAR; PG8_SCHED;
            PG8_LDB(B0, 1, 0); PG8_LDB(B1, 1, 1); PG8_SCHED; PG8_LDA(At, 1, 0); PG8_STAGE(PG8_SA(0, 1), a2 + hstepA, voffA);
            PG8_WAIT_V(8); PG8_WAIT_L(0); PG8_BAR; PG8_MMA(0, 0, At, B0); PG8_MMA(0, 1, At, B1); PG8_BAR; PG8_SCHED;
            PG8_LDA(At, 1, 1); PG8_STAGE(PG8_SB(1, 0), b3, voffB); PG8_STAGE(PG8_SB(1, 1), b3 + hstepB, voffB); PG8_STAGE(PG8_SA(1, 0), a3, voffA);
            PG8_WAIT_V(8); PG8_WAIT_L(0); PG8_BAR; PG8_MMA(1, 0, At, B0); PG8_MMA(1, 1, At, B1); PG8_BAR; PG8_SCHED;
        }
        if constexpr (ALIGN_EPI) { if (wr == 0) PG8_BAR; }
        if constexpr (!Epi::AFTER_DRAIN) { E(acc, cur, wr, wc, fr, fq); }
        if (!has_next) break;
        if (!nxt.keep) {
#pragma unroll
            for (int a = 0; a < 2; ++a)
#pragma unroll
                for (int b = 0; b < 2; ++b)
#pragma unroll
                    for (int m = 0; m < 4; ++m)
#pragma unroll
                        for (int n = 0; n < 2; ++n) acc[a][b][m][n] = (f32x4){0.f, 0.f, 0.f, 0.f};
        }
        cur = nxt; cA = nA; cB = nB; ++ui;
        if constexpr (ALIGN_EPI) { if (wr == 1) PG8_BAR; }
    }
    PG8_WAIT_V(0);
    if constexpr (!ALIGN_EPI) { if (wr == 0) PG8_BAR; }
    PG8_BAR;
    if constexpr (Epi::AFTER_DRAIN) { E.fused(acc, cur, wr, wc, fr, fq, lds, wid, lane); }
#undef PG8_SA
#undef PG8_SB
#undef PG8_STAGE
#undef PG8_LDA
#undef PG8_LDB
#undef PG8_MMA
#undef PG8_WAIT_V
#undef PG8_WAIT_L
#undef PG8_BAR
#undef PG8_SCHED
}

typedef f32x4 Acc[2][2][4][2];
#define EPI_ROWLOOP _Pragma("unroll") for (int ai = 0; ai < 2; ++ai) _Pragma("unroll") for (int m = 0; m < 4; ++m)

struct EpiUp {
    static constexpr bool AFTER_DRAIN = false;
    bf16_t* hid; const float* ssq;
    __device__ __forceinline__ void operator()(Acc& acc, const Unit& u, int wr, int wc, int fr, int fq) const {
        EPI_ROWLOOP { const int row = u.pm * BM + ai * HALF + wr * 64 + m * 16 + fr; const float r = rsqrtf(ssq[row] * (1.0f / DM) + EPS);
            f32x4 h[2];
#pragma unroll
            for (int n = 0; n < 2; ++n) { const f32x4 g = acc[ai][0][m][n] * r, up = acc[ai][1][m][n] * r;
#pragma unroll
                for (int j = 0; j < 4; ++j) h[n][j] = fsilu(g[j]) * up[j]; }
            *(u32x4*)(hid + (size_t)row * DFF + u.pn * 128 + wc * 32 + fq * 8) = pack8(h[0], h[1]); }
    }
};
struct EpiUp8 {
    static constexpr bool AFTER_DRAIN = false;
    bf16_t* hid; const float* cs; const float* rs;
    __device__ __forceinline__ void operator()(Acc& acc, const Unit& u, int wr, int wc, int fr, int fq) const {
        const int cb = u.pn * BM + wc * 32 + fq * 8;
        f32x4 sg[2], su[2];
#pragma unroll
        for (int n = 0; n < 2; ++n) { sg[n] = *(const f32x4*)(cs + cb + 4 * n); su[n] = *(const f32x4*)(cs + cb + HALF + 4 * n); }
        EPI_ROWLOOP { const int row = u.pm * BM + ai * HALF + wr * 64 + m * 16 + fr; const float r = rs[row];
            f32x4 h[2];
#pragma unroll
            for (int n = 0; n < 2; ++n) { const i32x4 gi = __builtin_bit_cast(i32x4, acc[ai][0][m][n]), ui = __builtin_bit_cast(i32x4, acc[ai][1][m][n]);
#pragma unroll
                for (int j = 0; j < 4; ++j) h[n][j] = fsilu((float)gi[j] * (sg[n][j] * r)) * ((float)ui[j] * (su[n][j] * r)); }
            *(u32x4*)(hid + (size_t)row * DFF + u.pn * 128 + wc * 32 + fq * 8) = pack8(h[0], h[1]); }
    }
};
struct EpiGate8 {
    static constexpr bool AFTER_DRAIN = false;
    bf16_t* gt; const float* cs; const float* rs;
    __device__ __forceinline__ void operator()(Acc& acc, const Unit& u, int wr, int wc, int fr, int fq) const {
        const int cb = u.pn * BM + wc * 32 + fq * 8;
        f32x4 sc[2][2];
#pragma unroll
        for (int bj = 0; bj < 2; ++bj)
#pragma unroll
            for (int n = 0; n < 2; ++n) sc[bj][n] = *(const f32x4*)(cs + cb + bj * HALF + 4 * n);
        EPI_ROWLOOP { const int row = u.pm * BM + ai * HALF + wr * 64 + m * 16 + fr; const float r = rs[row];
#pragma unroll
            for (int bj = 0; bj < 2; ++bj) { f32x4 v[2];
#pragma unroll
                for (int n = 0; n < 2; ++n) { const i32x4 zi = __builtin_bit_cast(i32x4, acc[ai][bj][m][n]);
#pragma unroll
                    for (int j = 0; j < 4; ++j) v[n][j] = fsigmoid((float)zi[j] * (sc[bj][n][j] * r)); }
                *(u32x4*)(gt + (size_t)row * 6144 + cb + bj * HALF) = pack8(v[0], v[1]); } }
    }
};
template <bool RB, bool OB, bool HALFA> struct EpiDownT {
    static constexpr bool AFTER_DRAIN = false; static constexpr float alpha = HALFA ? 0.5f : 1.0f;
    const void* res; void* out; bf16_t* xn; const float* g; float* ssq;
    __device__ __forceinline__ void operator()(Acc& acc, const Unit& u, int wr, int wc, int fr, int fq) const {
        const int col0 = u.pn * BM + wc * 32 + fq * 8;
        EPI_ROWLOOP { const int row = u.pm * BM + ai * HALF + wr * 64 + m * 16 + fr; float ss = 0.f;
#pragma unroll
            for (int bj = 0; bj < 2; ++bj) { const size_t off = (size_t)row * DM + col0 + bj * HALF;
                f32x4 r0, r1;
                if constexpr (RB) unpack8(*(const u32x4*)((const bf16_t*)res + off), r0, r1);
                else { r0 = *(const f32x4*)((const float*)res + off); r1 = *(const f32x4*)((const float*)res + off + 4); }
                const f32x4 h0 = r0 + acc[ai][bj][m][0] * alpha, h1 = r1 + acc[ai][bj][m][1] * alpha;
                if constexpr (OB) *(u32x4*)((bf16_t*)out + off) = pack8(h0, h1);
                else { *(f32x4*)((float*)out + off) = h0; *(f32x4*)((float*)out + off + 4) = h1; }
                ss += (h0[0] * h0[0] + h0[1] * h0[1]) + (h0[2] * h0[2] + h0[3] * h0[3]) + (h1[0] * h1[0] + h1[1] * h1[1]) + (h1[2] * h1[2] + h1[3] * h1[3]);
                if (xn) { const f32x4 g0 = *(const f32x4*)(g + col0 + bj * HALF), g1 = *(const f32x4*)(g + col0 + bj * HALF + 4); *(u32x4*)(xn + off) = pack8(h0 * g0, h1 * g1); } }
            ss += __shfl_xor(ss, 16); ss += __shfl_xor(ss, 32);
            if (fq == 0) atomicAdd(ssq + row, ss);
            asm volatile("" ::: "memory"); }
    }
};
struct EpiProj {
    static constexpr bool AFTER_DRAIN = false;
    unsigned char* ws; const float* ssq; const float* lb;
    __device__ __forceinline__ void operator()(Acc& acc, const Unit& u, int wr, int wc, int fr, int fq) const {
        const int grp = u.pn >> 2, cw = wc * 32 + fq * 8;
        EPI_ROWLOOP { const int row = u.pm * BM + ai * HALF + wr * 64 + m * 16 + fr; const float r = rsqrtf(ssq[row] * (1.0f / DM) + EPS);
#pragma unroll
            for (int bj = 0; bj < 2; ++bj) { f32x4 v0 = acc[ai][bj][m][0] * r, v1 = acc[ai][bj][m][1] * r;
                const int cc = (u.pn & 3) * 256 + bj * 128 + cw;
                if (grp < 3) {
                    bf16_t* T = (bf16_t*)(ws + WS_DQ + (size_t)grp * 16 * MiB); const int bl = row >> 12, t = row & 4095, g8 = cc >> 7;
                    *(u32x4*)(T + ((size_t)((bl * 8 + g8) * 4096 + t)) * 128 + (cc & 127)) = pack8(v0, v1);
                } else if (grp == 3) {
#pragma unroll
                    for (int j = 0; j < 4; ++j) { v0[j] = fsilu(v0[j]); v1[j] = fsilu(v1[j]); }
                    *(u32x4*)((bf16_t*)(ws + WS_HQ) + (size_t)row * 1024 + cc) = pack8(v0, v1);
                } else if (grp == 4) {
                    const f32x4 l0 = *(const f32x4*)(lb + cc), l1 = *(const f32x4*)(lb + cc + 4); f32x4 lf0, lf1, k0, k1;
#pragma unroll
                    for (int j = 0; j < 4; ++j) {
                        { const float z = fminf(fmaxf(v0[j], -30.f), 30.f), e = fexp(-z), sg = __builtin_amdgcn_rcpf(1.f + e), om = 1.f - l0[j]; lf0[j] = __logf(l0[j] + om * sg); k0[j] = om * e * sg; }
                        { const float z = fminf(fmaxf(v1[j], -30.f), 30.f), e = fexp(-z), sg = __builtin_amdgcn_rcpf(1.f + e), om = 1.f - l1[j]; lf1[j] = __logf(l1[j] + om * sg); k1[j] = om * e * sg; } }
                    float* LF = (float*)(ws + WS_HLF) + (size_t)row * 1024 + cc; *(f32x4*)LF = lf0; *(f32x4*)(LF + 4) = lf1;
                    *(u32x4*)((bf16_t*)(ws + WS_HK) + (size_t)row * 1024 + cc) = pack8(k0, k1);
                } else if (grp == 5) {
                    *(u32x4*)((bf16_t*)(ws + WS_HV) + (size_t)row * 1024 + cc) = pack8(v0, v1);
                } else if (grp == 6) {
#pragma unroll
                    for (int j = 0; j < 4; ++j) { v0[j] = fsigmoid(v0[j]); v1[j] = fsigmoid(v1[j]); }
                    *(u32x4*)((bf16_t*)(ws + WS_HG) + (size_t)row * 1024 + cc) = pack8(v0, v1);
                } else if (grp == 7) {
                    *(u32x4*)((bf16_t*)(ws + WS_XQ) + (size_t)row * 1024 + cc) = pack8(v0, v1);
                } else {
#pragma unroll
                    for (int j = 0; j < 4; ++j) { v0[j] = fsigmoid(v0[j]); v1[j] = fsigmoid(v1[j]); }
                    *(u32x4*)((bf16_t*)(ws + WS_GT) + (size_t)row * 6144 + (u.pn - 32) * 256 + bj * 128 + cw) = pack8(v0, v1);
                } } }
    }
};
struct EpiChain {
    static constexpr bool AFTER_DRAIN = false;
    const bf16_t* gt; bf16_t* out; float* pb;
    __device__ __forceinline__ void operator()(Acc& acc, const Unit& u, int wr, int wc, int fr, int fq) const {
        const int col0 = u.pn * BM + wc * 32 + fq * 8;
        if (u.sub > 0) { __builtin_amdgcn_fence(__ATOMIC_ACQUIRE, "agent"); }
        EPI_ROWLOOP { const int row = u.pm * BM + ai * HALF + wr * 64 + m * 16 + fr;
#pragma unroll
            for (int bj = 0; bj < 2; ++bj) { const bf16_t* gp = gt + (size_t)row * 6144 + u.sub * 2048 + col0 + bj * HALF; f32x4 a0, a1; unpack8(*(const u32x4*)gp, a0, a1);
                float* pp = pb + (size_t)row * DM + col0 + bj * HALF;
                f32x4 v0 = acc[ai][bj][m][0] * a0, v1 = acc[ai][bj][m][1] * a1;
                if (u.sub > 0) { v0 += *(const f32x4*)pp; v1 += *(const f32x4*)(pp + 4); }
                if (u.sub < 2) { *(f32x4*)pp = v0; *(f32x4*)(pp + 4) = v1; }
                else *(u32x4*)(out + (size_t)row * DM + col0 + bj * HALF) = pack8(v0, v1); }
            asm volatile("" ::: "memory"); }
    }
};
struct EpiStore {
    static constexpr bool AFTER_DRAIN = false;
    bf16_t* base; int ldc;
    __device__ __forceinline__ void operator()(Acc& acc, const Unit& u, int wr, int wc, int fr, int fq) const {
        EPI_ROWLOOP { const int r = ai * HALF + wr * 64 + m * 16 + fr;
#pragma unroll
            for (int bj = 0; bj < 2; ++bj) *(u32x4*)(base + (size_t)r * ldc + bj * HALF + wc * 32 + fq * 8) = pack8(acc[ai][bj][m][0], acc[ai][bj][m][1]); }
    }
};
struct EpiSoftmax {
    static constexpr bool AFTER_DRAIN = true;
    bf16_t* P; float scale;
    __device__ __forceinline__ void operator()(Acc&, const Unit&, int, int, int, int) const {}
    __device__ __forceinline__ void fused(Acc& acc, const Unit& u, int wr, int wc, int fr, int fq, LAS unsigned char* lds, int wid, int lane) const {
        LAS float* T1 = (LAS float*)lds; LAS float* T2 = (LAS float*)(lds + 4096);
        EPI_ROWLOOP { const int r = ai * HALF + wr * 64 + m * 16 + fr; float mx = -3.0e38f;
#pragma unroll
            for (int bj = 0; bj < 2; ++bj)
#pragma unroll
                for (int n = 0; n < 2; ++n)
#pragma unroll
                    for (int j = 0; j < 4; ++j) mx = fmaxf(mx, acc[ai][bj][m][n][j]);
            mx = fmaxf(mx, __shfl_xor(mx, 16)); mx = fmaxf(mx, __shfl_xor(mx, 32));
            if (fq == 0) T1[r * 4 + wc] = mx; }
        __syncthreads();
        const float c2 = scale * LOG2E;
        EPI_ROWLOOP { const int r = ai * HALF + wr * 64 + m * 16 + fr; const f32x4 mv = *(const LAS f32x4*)(T1 + r * 4); const float mx = fmaxf(fmaxf(mv[0], mv[1]), fmaxf(mv[2], mv[3])); float s = 0.f;
#pragma unroll
            for (int bj = 0; bj < 2; ++bj)
#pragma unroll
                for (int n = 0; n < 2; ++n)
#pragma unroll
                    for (int j = 0; j < 4; ++j) { const float e = __builtin_amdgcn_exp2f((acc[ai][bj][m][n][j] - mx) * c2); acc[ai][bj][m][n][j] = e; s += e; }
            s += __shfl_xor(s, 16); s += __shfl_xor(s, 32);
            if (fq == 0) T2[r * 4 + wc] = s; }
        __syncthreads();
        EPI_ROWLOOP { const int r = ai * HALF + wr * 64 + m * 16 + fr; const f32x4 sv = *(const LAS f32x4*)(T2 + r * 4); const float inv = __builtin_amdgcn_rcpf((sv[0] + sv[1]) + (sv[2] + sv[3]));
#pragma unroll
            for (int bj = 0; bj < 2; ++bj) *(u32x4*)(P + (size_t)r * 256 + bj * HALF + wc * 32 + fq * 8) = pack8(acc[ai][bj][m][0] * inv, acc[ai][bj][m][1] * inv); }
        __syncthreads();
    }
};
}

namespace att {
using bf16 = __hip_bfloat16;
constexpr int D = 128, NW = 8, QBLK = 32, KVBLK = 64, QB = NW * QBLK;
constexpr float SCALE = 0.08838834764831845f;
constexpr float THR = 8.f;
constexpr int SHM_V = KVBLK * D * 2, SHM_K = KVBLK * D * 2;
constexpr int LDS_BYTES = 2 * SHM_V + 2 * SHM_K + NW * 64 * 4;
#define KSWZ(row, colB) ((row) * 256 + ((colB) ^ (((row) & 7) << 4)))
#define SBAR() __builtin_amdgcn_sched_barrier(0)
__device__ __forceinline__ int v_st(int k, int c) { const int kk = (k & ~0xC) | ((k & 4) << 1) | ((k & 8) >> 1); return ((kk >> 3) * 4 + (c >> 5)) * 512 + ((kk & 7) * 32 + (c & 31)) * 2; }
__device__ __forceinline__ int v_rd_base(int lane) { return ((lane & 3) << 3) | (((lane >> 2) & 3) << 6) | (((lane >> 4) & 1) << 5) | (((lane >> 5) & 1) << 8); }
constexpr int v_rd_off(int d0, int ks, int half) { return d0 * 512 + ks * 4096 + half * 2048; }
__device__ __forceinline__ int crow(int r, int hi) { return (r & 3) + 8 * (r >> 2) + 4 * hi; }
__device__ __forceinline__ unsigned cvtpk(float lo, float hi) { return cvt_pk_bf16(lo, hi); }
__device__ __forceinline__ bf16x8 load8(const bf16* p) { return *reinterpret_cast<const bf16x8*>(p); }
__device__ __forceinline__ void mask_tile(f32x16& p0, f32x16& p1, int dq) {
    const float NEG = -__builtin_inff();
#pragma unroll
    for (int r = 0; r < 16; ++r) { const int c = (r & 3) + 8 * (r >> 2); if (dq - c < 0) p0[r] = NEG; if (dq - c - 32 < 0) p1[r] = NEG; }
}
__device__ __forceinline__ void partialSM(f32x16& p0, f32x16& p1, float& m_reg, float& mn, float& alpha) {
    float pmax = p0[0]; for (int r = 1; r < 16; ++r) pmax = fmaxf(pmax, p0[r]); for (int r = 0; r < 16; ++r) pmax = fmaxf(pmax, p1[r]);
    { auto rr = __builtin_amdgcn_permlane32_swap(__float_as_uint(pmax), __float_as_uint(pmax), false, false); pmax = fmaxf(__uint_as_float(rr[0]), __uint_as_float(rr[1])); }
    constexpr float C2 = 1.4426950408889634f * SCALE;
    if (__builtin_expect(__all((pmax - m_reg) * SCALE <= THR), 1)) { mn = m_reg; alpha = 1.f; }
    else { mn = fmaxf(m_reg, pmax); alpha = __builtin_amdgcn_exp2f((m_reg - mn) * C2); m_reg = mn; }
    const float mnL = -mn * C2;
    for (int r = 0; r < 16; ++r) p0[r] = fmaf(p0[r], C2, mnL); for (int r = 0; r < 16; ++r) p1[r] = fmaf(p1[r], C2, mnL);
    for (int r = 0; r < 16; ++r) p0[r] = __builtin_amdgcn_exp2f(p0[r]);
}
__device__ __forceinline__ void finishSM(f32x16& p0, f32x16& p1, float alpha, float& l_reg, bf16x8& pa0, bf16x8& pa1, bf16x8& pa2, bf16x8& pa3) {
    for (int r = 0; r < 16; ++r) p1[r] = __builtin_amdgcn_exp2f(p1[r]);
    float ps = 0; for (int r = 0; r < 16; ++r) ps += p0[r]; for (int r = 0; r < 16; ++r) ps += p1[r];
    { auto rr = __builtin_amdgcn_permlane32_swap(__float_as_uint(ps), __float_as_uint(ps), false, false); ps = __uint_as_float(rr[0]) + __uint_as_float(rr[1]); }
    l_reg = l_reg * alpha + ps;
#define PK4(P, B_, OUT) do { unsigned a0 = cvtpk(P[B_+0], P[B_+1]), a1 = cvtpk(P[B_+2], P[B_+3]); unsigned b0 = cvtpk(P[B_+4], P[B_+5]), b1 = cvtpk(P[B_+6], P[B_+7]); \
        auto r0 = __builtin_amdgcn_permlane32_swap(a0, b0, false, false); auto r1 = __builtin_amdgcn_permlane32_swap(a1, b1, false, false); \
        u32x4 w = {r0[0], r1[0], r0[1], r1[1]}; OUT = *reinterpret_cast<bf16x8*>(&w); } while (0)
    PK4(p0, 0, pa0); PK4(p0, 8, pa1); PK4(p1, 0, pa2); PK4(p1, 8, pa3);
#undef PK4
}
template <int KB>
__device__ __forceinline__ void qkt(f32x16& p0, f32x16& p1, const char* K_lds, int r32, int hi, const bf16x8* qr, float bb, float bs) {
    { const float bs2 = bs + bs, bs3 = bs2 + bs, bs8 = bs2 * 4.f, bs32 = bs8 * 4.f; float q = bb;
#pragma unroll
      for (int g = 0; g < 4; ++g) { p0[4 * g] = q; p0[4 * g + 1] = q + bs; p0[4 * g + 2] = q + bs2; p0[4 * g + 3] = q + bs3; q += bs8; }
#pragma unroll
      for (int r = 0; r < 16; ++r) p1[r] = p0[r] + bs32; }
    const char* kb[4];
#pragma unroll
    for (int dd = 0; dd < 4; ++dd) kb[dd] = K_lds + KB * SHM_K + KSWZ(r32, (dd * 16 + hi * 8) * 2);
#pragma unroll
    for (int d0 = 0; d0 < 8; ++d0) { const char* a = kb[d0 & 3] + (d0 >> 2) * 128;
        bf16x8 b0 = *reinterpret_cast<const bf16x8*>(a);
        bf16x8 b1 = *reinterpret_cast<const bf16x8*>(a + 32 * 256);
        p0 = __builtin_amdgcn_mfma_f32_32x32x16_bf16(b0, qr[d0], p0, 0, 0, 0);
        p1 = __builtin_amdgcn_mfma_f32_32x32x16_bf16(b1, qr[d0], p1, 0, 0, 0); }
}
template <int VB>
__device__ __forceinline__ void pv_tile(f32x16* o, int vb0, bf16x8 pa0, bf16x8 pa1, bf16x8 pa2, bf16x8 pa3) {
#define TRRD(dst, off) asm volatile("ds_read_b64_tr_b16 %0, %1 offset:%2" : "=&v"(dst) : "v"(vb0), "i"(off) : "memory")
#define PV_D0(d0) do { s16x4 l0, l1, l2, l3, h0, h1, h2, h3; constexpr int b_ = VB * SHM_V + v_rd_off(d0, 0, 0); \
        TRRD(l0, b_); TRRD(h0, b_ + 2048); TRRD(l1, b_ + 4096); TRRD(h1, b_ + 6144); TRRD(l2, b_ + 8192); TRRD(h2, b_ + 10240); TRRD(l3, b_ + 12288); TRRD(h3, b_ + 14336); \
        asm volatile("s_waitcnt lgkmcnt(0)" ::: "memory"); SBAR(); \
        o[d0] = __builtin_amdgcn_mfma_f32_32x32x16_bf16(pa0, (bf16x8){l0[0], l0[1], l0[2], l0[3], h0[0], h0[1], h0[2], h0[3]}, o[d0], 0, 0, 0); \
        o[d0] = __builtin_amdgcn_mfma_f32_32x32x16_bf16(pa1, (bf16x8){l1[0], l1[1], l1[2], l1[3], h1[0], h1[1], h1[2], h1[3]}, o[d0], 0, 0, 0); \
        o[d0] = __builtin_amdgcn_mfma_f32_32x32x16_bf16(pa2, (bf16x8){l2[0], l2[1], l2[2], l2[3], h2[0], h2[1], h2[2], h2[3]}, o[d0], 0, 0, 0); \
        o[d0] = __builtin_amdgcn_mfma_f32_32x32x16_bf16(pa3, (bf16x8){l3[0], l3[1], l3[2], l3[3], h3[0], h3[1], h3[2], h3[3]}, o[d0], 0, 0, 0); } while (0)
    PV_D0(0); PV_D0(1); PV_D0(2); PV_D0(3);
#undef PV_D0
#undef TRRD
}
struct BlockRef { const bf16* Q; const bf16* K; const bf16* V; bf16* O; int P0; float bs; };
#define VMW() asm volatile("s_waitcnt vmcnt(0)" ::: "memory")
#define SLOAD_H(Kp, Vp, k0) do { const char* kb_ = (const char*)(Kp) + (size_t)(k0) * (D * 2); const char* vb_ = (const char*)(Vp) + (size_t)(k0) * (D * 2); \
        st_v0 = *(const bf16x8*)(vb_ + slo); st_v1 = *(const bf16x8*)(vb_ + 32 * D * 2 + slo); st_k0 = *(const bf16x8*)(kb_ + slo); st_k1 = *(const bf16x8*)(kb_ + 32 * D * 2 + slo); } while (0)
#define SWRITE_H(bf) do { *(bf16x8*)(V_lds + (bf) * SHM_V + vst0) = st_v0; *(bf16x8*)(V_lds + (bf) * SHM_V + vst1) = st_v1; \
        *(bf16x8*)(K_lds + (bf) * SHM_K + kws) = st_k0; *(bf16x8*)(K_lds + (bf) * SHM_K + kws + 32 * 256) = st_k1; } while (0)
__device__ __forceinline__ void attn_block(const BlockRef& cur, char* lds) {
    int tid = threadIdx.x; asm volatile("" : "+v"(tid));
    const int wid = __builtin_amdgcn_readfirstlane(tid >> 6), lane = tid & 63, r32 = lane & 31, hi = lane >> 5;
    const int NT = cur.P0 / KVBLK + 4;
    const int qlo = cur.P0 + wid * QBLK, qm = qlo + r32 - 4 * hi;
    char* V_lds = lds; char* K_lds = lds + 2 * SHM_V;
    float* al_l = (float*)(lds + 2 * SHM_V + 2 * SHM_K) + wid * 64;
    float m_reg = -1e30f, l_reg = 0; f32x16 o[4] = {};
    const int sr = tid >> 4, sc = (tid & 15) * 8, vst0 = v_st(sr, sc), vst1 = v_st(32 + sr, sc), kws = KSWZ(sr, sc * 2);
    const int vb0 = (int)(uintptr_t)V_lds + v_rd_base(lane);
    const bf16* Kh = cur.K; const bf16* Vh = cur.V;
    const unsigned slo = (unsigned)((sr * D + sc) * 2), qlo_b = (unsigned)((r32 * D + hi * 8) * 2);
    const float bs = cur.bs, bb0 = bs * (float)(4 * hi - cur.P0);
    bf16x8 qr[8], st_v0, st_v1, st_k0, st_k1;
    { const char* qb_ = (const char*)cur.Q + (size_t)wid * (QBLK * D * 2);
#pragma unroll
      for (int d0 = 0; d0 < 8; ++d0) qr[d0] = *(const bf16x8*)(qb_ + qlo_b + d0 * 32); }
    SLOAD_H(Kh, Vh, 0); VMW(); SWRITE_H(0);
    __syncthreads();
    f32x16 p0, p1; float mn, al; bf16x8 pa0, pa1, pa2, pa3;
#define RESC(a) do { if (__any((a) < 1.f)) { if (hi == 0) al_l[r32] = (a); asm volatile("s_waitcnt lgkmcnt(0)" ::: "memory"); \
                     for (int d_ = 0; d_ < 4; ++d_) for (int r = 0; r < 16; ++r) o[d_][r] *= al_l[crow(r, hi)]; } } while (0)
#define STEP(t, BUF) do { const int kb_t = (t) * KVBLK; \
        if ((t) + 1 < NT) SLOAD_H(Kh, Vh, kb_t + KVBLK); \
        SBAR(); qkt<BUF>(p0, p1, K_lds, r32, hi, qr, fmaf(bs, (float)kb_t, bb0), bs); \
        if (kb_t + KVBLK - 1 > qlo) mask_tile(p0, p1, qm - kb_t); \
        partialSM(p0, p1, m_reg, mn, al); RESC(al); \
        finishSM(p0, p1, al, l_reg, pa0, pa1, pa2, pa3); SBAR(); \
        pv_tile<BUF>(o, vb0, pa0, pa1, pa2, pa3); \
        if ((t) + 1 < NT) { VMW(); SWRITE_H(1 - BUF); } \
        __syncthreads(); } while (0)
#pragma unroll 1
    for (int t = 0; t < NT; t += 2) { STEP(t, 0); STEP(t + 1, 1); }
#undef STEP
#undef RESC
    float* li_l = al_l;
    if (hi == 0) li_l[r32] = l_reg; asm volatile("s_waitcnt lgkmcnt(0)" ::: "memory");
    float rli[16];
#pragma unroll
    for (int r = 0; r < 16; ++r) rli[r] = __builtin_amdgcn_rcpf(li_l[crow(r, hi)]);
    char* Ow = (char*)cur.O + (size_t)wid * (QBLK * D * 2); const unsigned olo = (unsigned)((4 * hi * D + r32) * 2);
#pragma unroll
    for (int r = 0; r < 16; ++r) { const int orc = (r & 3) + 8 * (r >> 2);
#pragma unroll
        for (int d0 = 0; d0 < 4; ++d0) { const float v = o[d0][r] * rli[r]; const float vn = __shfl_xor(v, 1);
            if ((r32 & 1) == 0) *(unsigned*)(Ow + olo + orc * (D * 2) + d0 * 64) = cvtpk(v, vn); } }
    __syncthreads();
}
#undef VMW
#undef SLOAD_H
#undef SWRITE_H
}

struct Args {
    const float* in[26];
    float* out; unsigned char* ws;
};
enum { I_X = 0, I_MEM, I_F1N, I_F1G, I_F1U, I_F1D, I_MIXN, I_MEMNRM, I_WIN, I_LQ1, I_LK1, I_LQ2, I_LK2, I_SUBLN, I_LBL, I_HGN, I_WMKV, I_WBDA, I_WBHG, I_WBXA, I_WOUT, I_F2N, I_F2G, I_F2U, I_F2D, I_FINN };

__device__ __forceinline__ void transpose_item(const float* W, int ldw, int K, int N, bf16_t* WT, int row_off, int mode, LAS float* scr, int item, int lane) {
    const int nblk = N / 32, kb = item / nblk, nb = item % nblk, k0 = 64 * kb, n0 = 32 * nb;
#pragma unroll 8
    for (int i = 0; i < 32; ++i) { const int kk = 2 * i + (lane >> 5); scr[kk * 33 + (lane & 31)] = W[(size_t)(k0 + kk) * ldw + n0 + (lane & 31)]; }
    asm volatile("s_waitcnt lgkmcnt(0)" ::: "memory");
    const int c = lane & 7;
    const int d0 = mode == 0 ? row_off + n0 : ((n0 >> 7) * 256 + (n0 & 127) + (mode == 2 ? 128 : 0));
#pragma unroll
    for (int j = 0; j < 4; ++j) { const int n = (lane >> 3) + 8 * j; const LAS float* s = scr + (8 * c) * 33 + n;
        u32x4 o; o.x = cvt_pk_bf16(s[0 * 33], s[1 * 33]); o.y = cvt_pk_bf16(s[2 * 33], s[3 * 33]); o.z = cvt_pk_bf16(s[4 * 33], s[5 * 33]); o.w = cvt_pk_bf16(s[6 * 33], s[7 * 33]);
        *(u32x4*)(WT + (size_t)(d0 + n) * K + k0 + 8 * c) = o; }
    asm volatile("s_waitcnt lgkmcnt(0)" ::: "memory");
}
__device__ __forceinline__ void run_transpose(const float* W, int K, int N, bf16_t* WT, int row_off, int mode, LAS float* scr, int gw, int ngw, int lane, int ldw = 0) {
    if (ldw == 0) ldw = N;
    const int items = (K / 64) * (N / 32);
    for (int it = gw; it < items; it += ngw) transpose_item(W, ldw, K, N, WT, row_off, mode, scr, it, lane);
}

__device__ __forceinline__ unsigned q8(float v) { return (unsigned)((int)rintf(fminf(fmaxf(v, -127.f), 127.f))) & 0xffu; }
__device__ __forceinline__ unsigned q8x4(float a, float b, float c, float d) { return q8(a) | (q8(b) << 8) | (q8(c) << 16) | (q8(d) << 24); }
__device__ __forceinline__ void absmax_item(const float* W, int ldw, int N, unsigned* cmax, int mode, int up, int item, int lane) {
    const int nblk = N / 32, kb = item / nblk, nb = item % nblk, k0 = 64 * kb, n0 = 32 * nb; float mx = 0.f;
#pragma unroll 8
    for (int i = 0; i < 32; ++i) { const int kk = 2 * i + (lane >> 5); mx = fmaxf(mx, fabsf(W[(size_t)(k0 + kk) * ldw + n0 + (lane & 31)])); }
    mx = fmaxf(mx, __shfl_xor(mx, 32));
    if (lane < 32) atomicMax(cmax + (mode ? (n0 >> 7) * 256 + (n0 & 127) + up * 128 : n0) + lane, __float_as_uint(mx));
}
__device__ __forceinline__ void quant_item(const float* W, int ldw, int K, int N, unsigned char* W8, const unsigned* cmax, float* cs, int mode, int up, LAS float* scr, int item, int lane) {
    const int nblk = N / 32, kb = item / nblk, nb = item % nblk, k0 = 64 * kb, n0 = 32 * nb;
#pragma unroll 8
    for (int i = 0; i < 32; ++i) { const int kk = 2 * i + (lane >> 5); scr[kk * 33 + (lane & 31)] = W[(size_t)(k0 + kk) * ldw + n0 + (lane & 31)]; }
    asm volatile("s_waitcnt lgkmcnt(0)" ::: "memory");
    const int n = lane >> 1, hf = lane & 1, row = (mode ? (n0 >> 7) * 256 + (n0 & 127) + up * 128 : n0) + n;
    const float cm = fmaxf(__uint_as_float(cmax[row]), 1e-30f), sc = 127.0f / cm;
    const LAS float* sp = scr + (32 * hf) * 33 + n; unsigned w[8];
#pragma unroll
    for (int t = 0; t < 8; ++t) w[t] = q8x4(sp[(4 * t) * 33] * sc, sp[(4 * t + 1) * 33] * sc, sp[(4 * t + 2) * 33] * sc, sp[(4 * t + 3) * 33] * sc);
    unsigned char* dp = W8 + (size_t)row * K + k0 + 32 * hf;
    *(u32x4*)dp = (u32x4){w[0], w[1], w[2], w[3]}; *(u32x4*)(dp + 16) = (u32x4){w[4], w[5], w[6], w[7]};
    if (kb == 0 && hf == 0) cs[row] = cm * (1.0f / 127.0f);
    asm volatile("s_waitcnt lgkmcnt(0)" ::: "memory");
}
__device__ __forceinline__ f32x4 mfma16(bf16x8 a, bf16x8 b, f32x4 c) {
    f32x4 d = __builtin_amdgcn_mfma_f32_16x16x32_bf16(a, b, c, 0, 0, 0);
    asm volatile("" :: "v"(a), "v"(b));
    return d;
}
constexpr int BSTR = 132;
constexpr int HL_B = 0, HL_TOT = 64 * BSTR * 4, HL_Q1 = HL_TOT + 2048, HL_K1 = HL_Q1 + 17408, HL_Q2 = HL_K1 + 17408, HL_VT = HL_Q2 + 17408, HL_ST = HL_VT + 18432, HL_P = HL_ST + 34816, HL_RS = HL_P + 9216, HL_END = HL_RS + 512;
static_assert(HL_END <= LDS_BYTES, "hgrn lds");
constexpr int LDQ = 136, LDT = 72;
template <bool PASS_C>
__device__ __forceinline__ void hgrn_unit(unsigned char* lds, unsigned char* ws, const float* hg_norm, int bh, int c) {
    int tid = threadIdx.x; asm volatile("" : "+v"(tid));
    const int lane = tid & 63, wid = tid >> 6, fr = lane & 15, fq = lane >> 4;
    const int bl = bh >> 3, h = bh & 7; const size_t r0 = (size_t)bl * 4096 + (size_t)c * 64;
    float* bF = (float*)(lds + HL_B); float* tot = (float*)(lds + HL_TOT);
    bf16_t* Q1 = (bf16_t*)(lds + HL_Q1); bf16_t* K1 = (bf16_t*)(lds + HL_K1); bf16_t* Q2 = (bf16_t*)(lds + HL_Q2); bf16_t* VT = (bf16_t*)(lds + HL_VT);
    bf16_t* ST = (bf16_t*)(lds + HL_ST); bf16_t* Pm = (bf16_t*)(lds + HL_P); float* RS = (float*)(lds + HL_RS);
    const float* LF = (const float*)(ws + WS_HLF); const bf16_t* HQ = (const bf16_t*)(ws + WS_HQ); const bf16_t* HK = (const bf16_t*)(ws + WS_HK); const bf16_t* HV = (const bf16_t*)(ws + WS_HV);
    bf16_t* LS = (bf16_t*)(ws + WS_HGS) + ((size_t)(bh * 64 + c)) * 16384;
#pragma unroll
    for (int i = 0; i < 4; ++i) { const int e = tid + 512 * i, s = e >> 5, k4 = (e & 31) * 4; *(f32x4*)(bF + s * BSTR + k4) = *(const f32x4*)(LF + (r0 + s) * 1024 + h * 128 + k4); }
    u32x4 qv[2], kv[2];
#pragma unroll
    for (int i = 0; i < 2; ++i) { const int e = tid + 512 * i;
        { const int s = PASS_C ? (e >> 4) : (e & 63), k8 = PASS_C ? ((e & 15) * 8) : ((e >> 6) * 8); const size_t go = (r0 + s) * 1024 + h * 128 + k8;
          if (PASS_C) qv[i] = *(const u32x4*)(HQ + go);
          kv[i] = *(const u32x4*)(HK + go); }
        { const int s = e & 63, k8 = (e >> 6) * 8; const u32x4 vv = *(const u32x4*)(HV + (r0 + s) * 1024 + h * 128 + k8); const unsigned w[4] = {vv.x, vv.y, vv.z, vv.w};
#pragma unroll
          for (int j = 0; j < 4; ++j) { VT[(k8 + 2 * j) * LDT + s] = (bf16_t)(w[j] & 0xffffu); VT[(k8 + 2 * j + 1) * LDT + s] = (bf16_t)(w[j] >> 16); } } }
    if (PASS_C) {
#pragma unroll
        for (int i = 0; i < 4; ++i) { const int e = tid + 512 * i, v = e >> 4, k8 = (e & 15) * 8; u32x4 w_ = TESTZEROST ? (u32x4){0u, 0u, 0u, 0u} : *(const u32x4*)(LS + v * 128 + k8);
#if TESTSANST
            { unsigned ww[4] = {w_.x, w_.y, w_.z, w_.w};
#pragma unroll
              for (int j = 0; j < 4; ++j) { if ((ww[j] & 0x7f80u) > 0x4d00u) ww[j] &= 0xffff0000u; if ((ww[j] & 0x7f800000u) > 0x4d000000u) ww[j] &= 0x0000ffffu; }
              w_ = (u32x4){ww[0], ww[1], ww[2], ww[3]}; }
#endif
            *(u32x4*)(ST + v * LDQ + k8) = w_; } }
    __syncthreads();
    { const int k = tid & 127, seg = tid >> 7; float run = 0.f;
#pragma unroll
        for (int s = 0; s < 16; ++s) { run += bF[(seg * 16 + s) * BSTR + k]; bF[(seg * 16 + s) * BSTR + k] = run; }
        tot[seg * 128 + k] = run; }
    __syncthreads();
    { const int k = tid & 127, seg = tid >> 7; float pre = 0.f;
        for (int g = 0; g < seg; ++g) pre += tot[g * 128 + k];
        if (seg > 0) {
#pragma unroll
            for (int s = 0; s < 16; ++s) bF[(seg * 16 + s) * BSTR + k] += pre; } }
    __syncthreads();
#pragma unroll
    for (int i = 0; i < 2; ++i) { const int e = tid + 512 * i, s = PASS_C ? (e >> 4) : (e & 63), k8 = PASS_C ? ((e & 15) * 8) : ((e >> 6) * 8);
        f32x4 k0, k1; unpack8(kv[i], k0, k1);
        const f32x4 b0 = *(const f32x4*)(bF + s * BSTR + k8), b1 = *(const f32x4*)(bF + s * BSTR + k8 + 4);
        if (PASS_C) {
            f32x4 q0, q1; unpack8(qv[i], q0, q1);
            const f32x4 m0 = *(const f32x4*)(bF + 31 * BSTR + k8), m1 = *(const f32x4*)(bF + 31 * BSTR + k8 + 4);
            f32x4 a0, a1, c0, c1, d0, d1;
#pragma unroll
            for (int j = 0; j < 4; ++j) { a0[j] = q0[j] * fexp(b0[j] - m0[j]); a1[j] = q1[j] * fexp(b1[j] - m1[j]); c0[j] = k0[j] * fexp(m0[j] - b0[j]); c1[j] = k1[j] * fexp(m1[j] - b1[j]);
                d0[j] = q0[j] * fexp(b0[j]); d1[j] = q1[j] * fexp(b1[j]); }
            *(u32x4*)(Q1 + s * LDQ + k8) = pack8(a0, a1); *(u32x4*)(K1 + s * LDQ + k8) = pack8(c0, c1); *(u32x4*)(Q2 + s * LDQ + k8) = pack8(d0, d1);
        } else {
            const f32x4 e0 = *(const f32x4*)(bF + 63 * BSTR + k8), e1 = *(const f32x4*)(bF + 63 * BSTR + k8 + 4);
            bf16_t* KT = Q1;
#pragma unroll
            for (int j = 0; j < 4; ++j) { const unsigned w0 = cvt_pk_bf16(k0[j] * fexp(e0[j] - b0[j]), 0.f), w1 = cvt_pk_bf16(k1[j] * fexp(e1[j] - b1[j]), 0.f);
                KT[(k8 + j) * LDT + s] = (bf16_t)(w0 & 0xffffu); KT[(k8 + 4 + j) * LDT + s] = (bf16_t)(w1 & 0xffffu); }
        } }
    if (!PASS_C) { if (tid < 128) ((float*)(ws + WS_HGD))[(size_t)(bh * 64 + c) * 128 + tid] = fexp(bF[63 * BSTR + tid]); }
    __syncthreads();
    if (!PASS_C) {
        const bf16_t* KT = Q1;
        const bf16x8 a0 = *(const bf16x8*)(KT + (16 * wid + fr) * LDT + 8 * fq), a1 = *(const bf16x8*)(KT + (16 * wid + fr) * LDT + 32 + 8 * fq);
#pragma unroll
        for (int tv = 0; tv < 8; ++tv) { f32x4 acc = {0.f, 0.f, 0.f, 0.f};
            const bf16x8 b0 = *(const bf16x8*)(VT + (16 * tv + fr) * LDT + 8 * fq), b1 = *(const bf16x8*)(VT + (16 * tv + fr) * LDT + 32 + 8 * fq);
            acc = mfma16(a0, b0, acc); acc = mfma16(a1, b1, acc);
            u32x2 o; o.x = cvt_pk_bf16(acc[0], acc[1]); o.y = cvt_pk_bf16(acc[2], acc[3]);
#if TESTCONSTL
            o.x = 0x3c003c00u; o.y = 0x3c003c00u;
#endif
            *(u32x2*)(LS + (size_t)(16 * tv + fr) * 128 + 16 * wid + 4 * fq) = o; }
    } else {
#pragma unroll
        for (int q = 0; q < 2; ++q) { const int tile = wid + 8 * q, tt = tile >> 2, ts = tile & 3; f32x4 acc = {0.f, 0.f, 0.f, 0.f};
            if (ts <= tt) {
#pragma unroll
                for (int ks = 0; ks < 4; ++ks) { const bf16x8 a = *(const bf16x8*)(K1 + (16 * ts + fr) * LDQ + 32 * ks + 8 * fq), b = *(const bf16x8*)(Q1 + (16 * tt + fr) * LDQ + 32 * ks + 8 * fq);
                    acc = mfma16(a, b, acc); } }
            const int t = 16 * tt + fr, s0 = 16 * ts + 4 * fq;
#pragma unroll
            for (int i = 0; i < 4; ++i) if (s0 + i > t) acc[i] = 0.f;
            u32x2 o; o.x = cvt_pk_bf16(acc[0], acc[1]); o.y = cvt_pk_bf16(acc[2], acc[3]);
            *(u32x2*)(Pm + t * LDT + s0) = o; }
        __syncthreads();
        const int tt = wid & 3, vh = wid >> 2; f32x4 oacc[4]; float ss = 0.f;
        const bf16x8 p0 = *(const bf16x8*)(Pm + (16 * tt + fr) * LDT + 8 * fq), p1 = *(const bf16x8*)(Pm + (16 * tt + fr) * LDT + 32 + 8 * fq);
        bf16x8 q2[4];
#pragma unroll
        for (int ks = 0; ks < 4; ++ks) q2[ks] = *(const bf16x8*)(Q2 + (16 * tt + fr) * LDQ + 32 * ks + 8 * fq);
#pragma unroll
        for (int j = 0; j < 4; ++j) { const int tv = 4 * vh + j; f32x4 acc = {0.f, 0.f, 0.f, 0.f};
            acc = mfma16(*(const bf16x8*)(VT + (16 * tv + fr) * LDT + 8 * fq), p0, acc);
            acc = mfma16(*(const bf16x8*)(VT + (16 * tv + fr) * LDT + 32 + 8 * fq), p1, acc);
#if !TESTNOSTATE
#pragma unroll
            for (int ks = 0; ks < 4; ++ks) acc = mfma16(*(const bf16x8*)(ST + (16 * tv + fr) * LDQ + 32 * ks + 8 * fq), q2[ks], acc);
#endif
            oacc[j] = acc; ss += (acc[0] * acc[0] + acc[1] * acc[1]) + (acc[2] * acc[2] + acc[3] * acc[3]); }
        ss += __shfl_xor(ss, 16); ss += __shfl_xor(ss, 32);
        if (fq == 0) RS[(16 * tt + fr) * 2 + vh] = ss;
        __syncthreads();
        const float rinv = rsqrtf((RS[(16 * tt + fr) * 2] + RS[(16 * tt + fr) * 2 + 1]) * (1.0f / 128.f) + EPS);
        const size_t row = r0 + 16 * tt + fr; const bf16_t* HGp = (const bf16_t*)(ws + WS_HG); bf16_t* Y = (bf16_t*)(ws + WS_HQ);
#pragma unroll
        for (int j = 0; j < 4; ++j) { const int col = h * 128 + 16 * (4 * vh + j) + 4 * fq; const f32x4 gn = *(const f32x4*)(hg_norm + col); const u32x2 gw = *(const u32x2*)(HGp + row * 1024 + col);
            const float y0 = oacc[j][0] * rinv * gn[0] * bf_lo(gw.x), y1 = oacc[j][1] * rinv * gn[1] * bf_hi(gw.x), y2 = oacc[j][2] * rinv * gn[2] * bf_lo(gw.y), y3 = oacc[j][3] * rinv * gn[3] * bf_hi(gw.y);
            u32x2 o; o.x = cvt_pk_bf16(y0, y1); o.y = cvt_pk_bf16(y2, y3); *(u32x2*)(Y + row * 1024 + col) = o; }
    }
    __syncthreads();
}

#define XB_TMO      128
#define XB_XCNT(j)  (256  + 64 * (j))
#define XB_XSUB(j)  (1280 + 64 * (j))
#define XB_XGEN(j)  (2304 + 64 * (j))
#define XB_TOP      3328
#define XB_TOPGEN   3392
#define XCD_BAR_WORDS 3456
#define XB_SPIN_CAP (1u << 20)
__device__ __forceinline__ unsigned xb_ld(unsigned* p)              { return __hip_atomic_load(p, __ATOMIC_RELAXED, __HIP_MEMORY_SCOPE_AGENT); }
__device__ __forceinline__ unsigned xb_add(unsigned* p, unsigned v) { return __hip_atomic_fetch_add(p, v, __ATOMIC_RELAXED, __HIP_MEMORY_SCOPE_AGENT); }
__device__ __forceinline__ unsigned xb_xcc_id() { return (unsigned)__builtin_amdgcn_s_getreg((3 << 11) | 20) & 0xFu; }
#define XB_SPIN(cond, bar) do { unsigned _sp = 0; while (cond) { __builtin_amdgcn_s_sleep(1); \
    if ((++_sp & 255u) == 0u) { if (xb_ld(&(bar)[XB_TMO])) break; if (_sp > XB_SPIN_CAP) { atomicAdd(&(bar)[XB_TMO], 1u); break; } } } } while (0)
struct XcdBarrier { unsigned* bar; unsigned x; volatile LAS unsigned* st; };
__device__ __forceinline__ XcdBarrier xcd_barrier_post(unsigned* bar, volatile LAS unsigned* st) {
    XcdBarrier b; b.bar = bar; b.x = xb_xcc_id(); b.st = st;
    if (threadIdx.x == 0) (void)xb_add(&bar[XB_XCNT(b.x)], 1u);
    return b;
}
__device__ __forceinline__ void xcd_barrier_complete(unsigned* bar, unsigned x, unsigned& nloc, unsigned& nx) {
    const unsigned G = gridDim.x * gridDim.y * gridDim.z;
    unsigned sum, cnt, mine, sp = 0u;
    for (;;) {
        sum = 0u; cnt = 0u; mine = 0u;
#pragma unroll
        for (unsigned j = 0; j < 16; ++j) { const unsigned c = xb_ld(&bar[XB_XCNT(j)]); sum += c; cnt += (c > 0u) ? 1u : 0u; mine = (j == x) ? c : mine; }
        if (sum == G) break;
        __builtin_amdgcn_s_sleep(1);
        if ((++sp & 255u) == 0u) { if (xb_ld(&bar[XB_TMO])) break; if (sp > XB_SPIN_CAP) { atomicAdd(&bar[XB_TMO], 1u); break; } }
    }
    nloc = mine > 0u ? mine : 1u; nx = cnt > 0u ? cnt : 1u;
}
__device__ __forceinline__ void xcd_barrier(const XcdBarrier& b) {
    asm volatile("s_waitcnt vmcnt(0) lgkmcnt(0)" ::: "memory");
    __syncthreads();
    if (threadIdx.x == 0) {
        unsigned* bar = b.bar;
        __builtin_amdgcn_s_waitcnt(0);
        unsigned nloc = b.st[0], nx = b.st[1];
        if (nloc == 0u) { xcd_barrier_complete(bar, b.x, nloc, nx); b.st[0] = nloc; b.st[1] = nx; }
        const unsigned old = xb_add(&bar[XB_XSUB(b.x)], 1u);
        const unsigned gen = old / nloc;
        if (old + 1u == (gen + 1u) * nloc) {
            __builtin_amdgcn_fence(__ATOMIC_RELEASE, "agent");
            asm volatile("s_waitcnt vmcnt(0)" ::: "memory");
            const unsigned og = xb_add(&bar[XB_TOP], 1u);
            const unsigned tg = og / nx;
            if (og + 1u == (tg + 1u) * nx) xb_add(&bar[XB_TOPGEN], 1u);
            else XB_SPIN(xb_ld(&bar[XB_TOPGEN]) == tg, bar);
            __builtin_amdgcn_fence(__ATOMIC_ACQUIRE, "agent");
            xb_add(&bar[XB_XGEN(b.x)], 1u);
            asm volatile("s_waitcnt vmcnt(0)" ::: "memory");
        } else {
            XB_SPIN(xb_ld(&bar[XB_XGEN(b.x)]) == gen, bar);
            __builtin_amdgcn_fence(__ATOMIC_ACQUIRE, "agent");
            asm volatile("s_waitcnt vmcnt(0)" ::: "memory");
        }
    }
    __syncthreads();
}

#ifdef ONLY
#define PH(n) ((n) == ONLY)
#else
#define PH(n) 1
#endif
__global__ void __launch_bounds__(512) fwd_megakernel(Args args) {
    extern __shared__ __attribute__((aligned(16))) unsigned char lds[];
    cg::grid_group grid = cg::this_grid();
    LAS unsigned char* ldsL = (LAS unsigned char*)lds;
    unsigned char* ws = args.ws;
    const int G = gridDim.x, bx = blockIdx.x, NGW = G * 8;
    { volatile LAS unsigned* st0 = (volatile LAS unsigned*)(ldsL + LDS_MISC); if (threadIdx.x < 4) st0[threadIdx.x] = 0u; }
    __syncthreads();
    const XcdBarrier xbar = xcd_barrier_post((unsigned*)(args.ws + WS_CTL), (volatile LAS unsigned*)(ldsL + LDS_MISC));
#define GRID_SYNC() xcd_barrier(xbar)
#define IDS() int tid = threadIdx.x; asm volatile("" : "+v"(tid)); const int lane = tid & 63, wave = __builtin_amdgcn_readfirstlane(tid >> 6), gw = bx * 8 + wave; (void)lane; (void)gw
    float* ssq = (float*)(ws + WS_SSQ);
    float* lbp = (float*)(ws + WS_LB);
    float* out = args.out;
    bf16_t* XA = (bf16_t*)(ws + WS_XA); bf16_t* XB = (bf16_t*)(ws + WS_XB); bf16_t* HID = (bf16_t*)(ws + WS_HID);
    bf16_t* WGU = (bf16_t*)(ws + WS_WGU); bf16_t* WD = (bf16_t*)(ws + WS_WD); bf16_t* WIN = (bf16_t*)(ws + WS_WIN); bf16_t* WMK = (bf16_t*)(ws + WS_WMK);
    bf16_t* WBR = (bf16_t*)(ws + WS_WBR); bf16_t* WO = (bf16_t*)(ws + WS_WO); bf16_t* MEMN = (bf16_t*)(ws + WS_MEMN);

    {
        IDS(); LAS float* scr = (LAS float*)(ldsL + wave * 16384);
        { unsigned* cm1 = (unsigned*)(ws + WS_CMAX1); const int items = (DM / 64) * (DFF / 32);
          for (int it = gw; it < items; it += NGW) { absmax_item(args.in[I_F1G], DFF, DFF, cm1, 1, 0, it, lane); absmax_item(args.in[I_F1U], DFF, DFF, cm1, 1, 1, it, lane); }
          unsigned* cmg = (unsigned*)(ws + WS_CMAXG); const int itg = (DM / 64) * (6144 / 32);
          for (int it = gw; it < itg; it += NGW) absmax_item(args.in[I_WIN] + 8192, INCOLS, 6144, cmg, 0, 0, it, lane); }
        run_transpose(args.in[I_F1D], DFF, DM, WD, 0, 0, scr, gw, NGW, lane);
        run_transpose(args.in[I_WIN], DM, 8192, WIN, 0, 0, scr, gw, NGW, lane, INCOLS);
        run_transpose(args.in[I_WMKV], DM, 2048, WMK, 0, 0, scr, gw, NGW, lane);
        run_transpose(args.in[I_WBDA], 1024, DM, WBR, 0, 0, scr, gw, NGW, lane);
        run_transpose(args.in[I_WBHG], 1024, DM, WBR, 2048, 0, scr, gw, NGW, lane);
        run_transpose(args.in[I_WBXA], 1024, DM, WBR, 4096, 0, scr, gw, NGW, lane);
        run_transpose(args.in[I_WOUT], DM, DM, WO, 0, 0, scr, gw, NGW, lane);
        const float* x = args.in[I_X]; const float* g1 = args.in[I_F1N]; unsigned char* XA8 = (unsigned char*)XA;
        for (int m = gw; m < MTOK; m += NGW) { const f32x4* xr = (const f32x4*)(x + (size_t)m * DM); f32x4 a[4], b[4]; float s = 0.f;
#pragma unroll
            for (int j = 0; j < 4; ++j) { const int c8 = lane + 64 * j; a[j] = xr[2 * c8]; b[j] = xr[2 * c8 + 1];
                s += (a[j][0] * a[j][0] + a[j][1] * a[j][1]) + (a[j][2] * a[j][2] + a[j][3] * a[j][3]) + (b[j][0] * b[j][0] + b[j][1] * b[j][1]) + (b[j][2] * b[j][2] + b[j][3] * b[j][3]); }
            s = wave_sum(s); float am = 0.f;
#pragma unroll
            for (int j = 0; j < 4; ++j) { const int c8 = lane + 64 * j; const f32x4 ga = *(const f32x4*)(g1 + 8 * c8), gb = *(const f32x4*)(g1 + 8 * c8 + 4); a[j] = a[j] * ga; b[j] = b[j] * gb;
#pragma unroll
                for (int q = 0; q < 4; ++q) am = fmaxf(am, fmaxf(fabsf(a[j][q]), fabsf(b[j][q]))); }
#pragma unroll
            for (int o = 1; o < 64; o <<= 1) am = fmaxf(am, __shfl_xor(am, o));
            am = fmaxf(am, 1e-30f); const float r = 127.0f / am;
#pragma unroll
            for (int j = 0; j < 4; ++j) { const int c8 = lane + 64 * j;
                u32x2 o; o.x = q8x4(a[j][0] * r, a[j][1] * r, a[j][2] * r, a[j][3] * r); o.y = q8x4(b[j][0] * r, b[j][1] * r, b[j][2] * r, b[j][3] * r);
                *(u32x2*)(XA8 + (size_t)m * DM + 8 * c8) = o; }
            if (lane == 0) { ssq[m] = am * (1.0f / 127.0f) * rsqrtf(s * (1.0f / DM) + EPS); ssq[MTOK + m] = 0.f; ssq[2 * MTOK + m] = 0.f; ssq[3 * MTOK + m] = 0.f; } }
        const float* mem = args.in[I_MEM]; const float* gm = args.in[I_MEMNRM];
        for (int m = gw; m < NB * MEMLEN; m += NGW) { const f32x4* xr = (const f32x4*)(mem + (size_t)m * DM); f32x4 a[4], b[4]; float s = 0.f;
#pragma unroll
            for (int j = 0; j < 4; ++j) { const int c8 = lane + 64 * j; a[j] = xr[2 * c8]; b[j] = xr[2 * c8 + 1];
                s += (a[j][0] * a[j][0] + a[j][1] * a[j][1]) + (a[j][2] * a[j][2] + a[j][3] * a[j][3]) + (b[j][0] * b[j][0] + b[j][1] * b[j][1]) + (b[j][2] * b[j][2] + b[j][3] * b[j][3]); }
            const float r = rsqrtf(wave_sum(s) * (1.0f / DM) + EPS);
#pragma unroll
            for (int j = 0; j < 4; ++j) { const int c8 = lane + 64 * j; const f32x4 ga = *(const f32x4*)(gm + 8 * c8), gb = *(const f32x4*)(gm + 8 * c8 + 4);
                *(u32x4*)(MEMN + (size_t)m * DM + 8 * c8) = pack8(a[j] * ga * r, b[j] * gb * r); } }
        if (bx == 0) { const float* lbl = args.in[I_LBL];
            for (int j = tid; j < 1024; j += 512) lbp[j] = 1.0f / (1.0f + expf(lbl[1024 + j] - lbl[j]));
            if (wave == 0) { const float* q1 = args.in[I_LQ1]; const float* k1 = args.in[I_LK1]; const float* q2 = args.in[I_LQ2]; const float* k2 = args.in[I_LK2];
                float s1 = q1[lane] * k1[lane] + q1[lane + 64] * k1[lane + 64], s2 = q2[lane] * k2[lane] + q2[lane + 64] * k2[lane + 64];
                s1 = wave_sum(s1); s2 = wave_sum(s2); if (lane == 0) *(float*)(ws + WS_LAM) = expf(s1) - expf(s2) + 0.2f; } }
    }
    GRID_SYNC();
    { IDS(); LAS float* scr = (LAS float*)(ldsL + wave * 16384); const unsigned* cm1 = (const unsigned*)(ws + WS_CMAX1); float* cs1 = (float*)(ws + WS_CS1); const int items = (DM / 64) * (DFF / 32);
      for (int it = gw; it < items; it += NGW) { quant_item(args.in[I_F1G], DFF, DM, DFF, (unsigned char*)WGU, cm1, cs1, 1, 0, scr, it, lane); quant_item(args.in[I_F1U], DFF, DM, DFF, (unsigned char*)WGU, cm1, cs1, 1, 1, scr, it, lane); }
      const int itg = (DM / 64) * (6144 / 32);
      for (int it = gw; it < itg; it += NGW) quant_item(args.in[I_WIN] + 8192, INCOLS, DM, 6144, (unsigned char*)(WIN + (size_t)8192 * DM), (const unsigned*)(ws + WS_CMAXG), (float*)(ws + WS_CSG), 0, 0, scr, it, lane); }
    GRID_SYNC();
    if (args.out == nullptr) grid.sync();

    {
        pg8::StdOrder S; S.T.init(MTOK / 256, 2 * DFF / 256, G, bx); S.A = (const char*)XA; S.B = (const char*)WGU; S.a_t = (size_t)256 * DM; S.b_t = (size_t)256 * DM;
        pg8::EpiUp8 E{HID, (const float*)(ws + WS_CS1), ssq};
        if (PH(10)) pg8::gemm_phase<pg8::EpiUp8, pg8::StdOrder, true, true>(ldsL, DM / 2, DM / 2, DM / 2, S, E);
        pg8::OneUnit O; O.have = bx < 32; pg8::EpiStore ES{nullptr, 256};
        if (bx < 16) { const int pm = bx >> 2, pn = bx & 3; O.u0 = pg8::Unit{(const char*)(MEMN + (size_t)pm * 256 * DM), (const char*)(WMK + (size_t)pn * 256 * DM), pm, pn, 0, 0}; ES.base = (bf16_t*)(ws + WS_KMEM) + (size_t)(pm * 4 + pn) * 65536; }
        else if (bx < 32) { const int q = bx - 16, pm = q >> 2, pn = q & 3; O.u0 = pg8::Unit{(const char*)(WMK + (size_t)(1024 + pm * 256) * DM), (const char*)(MEMN + (size_t)pn * 256 * DM), pm, pn, 0, 0}; ES.base = (bf16_t*)(ws + WS_VTM) + (size_t)(pn * 4 + pm) * 65536; }
        else O.u0 = pg8::Unit{nullptr, nullptr, 0, 0, 0, 0};
        if (PH(11)) pg8::gemm_phase<pg8::EpiStore, pg8::OneUnit, false>(ldsL, DM, DM, DM, O, ES);
    }
    GRID_SYNC();
    {
        pg8::StdOrder S; S.T.init(MTOK / 256, DM / 256, G, bx); S.A = (const char*)HID; S.B = (const char*)WD; S.a_t = (size_t)256 * DFF * 2; S.b_t = (size_t)256 * DFF * 2;
        pg8::EpiDownT<false, true, true> E{args.in[I_X], out, XA, args.in[I_MIXN], ssq + MTOK};
        if (PH(12)) pg8::gemm_phase<pg8::EpiDownT<false, true, true>, pg8::StdOrder, true>(ldsL, DFF, DFF, DFF, S, E);
    }
    GRID_SYNC();
    {
        IDS(); unsigned char* X8 = (unsigned char*)(ws + WS_XA8G);
        for (int m = gw; m < MTOK; m += NGW) { f32x4 a[4], b[4]; float am = 0.f;
#pragma unroll
            for (int j = 0; j < 4; ++j) { const int c8 = lane + 64 * j; unpack8(*(const u32x4*)(XA + (size_t)m * DM + 8 * c8), a[j], b[j]);
#pragma unroll
                for (int q = 0; q < 4; ++q) am = fmaxf(am, fmaxf(fabsf(a[j][q]), fabsf(b[j][q]))); }
#pragma unroll
            for (int o = 1; o < 64; o <<= 1) am = fmaxf(am, __shfl_xor(am, o));
            am = fmaxf(am, 1e-30f); const float r = 127.0f / am;
#pragma unroll
            for (int j = 0; j < 4; ++j) { const int c8 = lane + 64 * j;
                u32x2 o; o.x = q8x4(a[j][0] * r, a[j][1] * r, a[j][2] * r, a[j][3] * r); o.y = q8x4(b[j][0] * r, b[j][1] * r, b[j][2] * r, b[j][3] * r);
                *(u32x2*)(X8 + (size_t)m * DM + 8 * c8) = o; }
            if (lane == 0) ssq[m] = am * (1.0f / 127.0f) * rsqrtf(ssq[MTOK + m] * (1.0f / DM) + EPS); }
    }
    GRID_SYNC();

#if TESTMODE == 1
    { IDS(); LAS float* scr = (LAS float*)(ldsL + wave * 16384);
      run_transpose(args.in[I_F2G], DM, DFF, WGU, 0, 1, scr, gw, NGW, lane); run_transpose(args.in[I_F2U], DM, DFF, WGU, 0, 2, scr, gw, NGW, lane); run_transpose(args.in[I_F2D], DFF, DM, WD, 0, 0, scr, gw, NGW, lane); }
    GRID_SYNC();
#else
    for (int half = 0; half < 2; ++half) {
        const size_t hrow = (size_t)half * HROWS;
        {
            pg8::StdOrder S; S.T.init(HROWS / 256, 8192 / 256, G, bx); S.A = (const char*)(XA + hrow * DM); S.B = (const char*)WIN; S.a_t = (size_t)256 * DM * 2; S.b_t = (size_t)256 * DM * 2;
            pg8::EpiProj E{ws, ssq + MTOK + hrow, lbp};
            if (PH(13)) pg8::gemm_phase<pg8::EpiProj, pg8::StdOrder, true>(ldsL, DM, DM, DM, S, E);
            pg8::StdOrder S8; S8.T.init(HROWS / 256, 6144 / 256, G, bx); S8.A = (const char*)(ws + WS_XA8G) + hrow * DM; S8.B = (const char*)(WIN + (size_t)8192 * DM); S8.a_t = (size_t)256 * DM; S8.b_t = (size_t)256 * DM;
            pg8::EpiGate8 E8{(bf16_t*)(ws + WS_GT), (const float*)(ws + WS_CSG), ssq + hrow};
            pg8::gemm_phase<pg8::EpiGate8, pg8::StdOrder, true, true>(ldsL, DM / 2, DM / 2, DM / 2, S8, E8);
        }
        GRID_SYNC();
        {
            using att::bf16;
#if PH(1) && !(TESTSKIP & 1)
            for (int L = bx; L < 256; L += G) {
                const int xcd = L & 7, k = L >> 3, bl = xcd >> 2, h = xcd & 3, c = k >> 4, vh = (k >> 3) & 1, pr = k & 7;
                const bf16* Qb = (const bf16*)(ws + WS_DQ) + (size_t)((bl * 8 + h * 2 + c) * 4096) * 128;
                const bf16* Kb = (const bf16*)(ws + WS_DK) + (size_t)((bl * 8 + h * 2 + c) * 4096) * 128;
                const bf16* Vb = (const bf16*)(ws + WS_DV) + (size_t)((bl * 8 + h * 2 + vh) * 4096) * 128;
                bf16* Ob = (bf16*)(ws + WS_OB) + (size_t)((((bl * 4 + h) * 2 + c) * 2 + vh) * 4096) * 128;
                const float slope = exp2f(-2.0f * (float)(h + 1)), bsl = slope / att::SCALE;
#pragma unroll 1
                for (int pass = 0; pass < 2; ++pass) { const int qb = pass ? 15 - pr : pr;
                    att::BlockRef cur{Qb + (size_t)qb * 256 * 128, Kb, Vb, Ob + (size_t)qb * 256 * 128, qb * 256, bsl};
                    att::attn_block(cur, (char*)lds); }
            }
#endif
            asm volatile("s_waitcnt vmcnt(0)" ::: "memory");
            __syncthreads();
#if !(TESTSKIP & 2)
            for (int it = bx; it < 128; it += G) {
                const int tl = it >> 2, h = it & 3, bgl = half * 2 + (tl >> 4);
                bf16_t* XQ = (bf16_t*)(ws + WS_XQ) + (size_t)tl * 256 * 1024 + h * 256;
                bf16_t* Ps = (bf16_t*)(ws + WS_PSCR) + (size_t)bx * 65536;
                pg8::OneUnit O; O.have = true;
                O.u0 = pg8::Unit{(const char*)XQ, (const char*)((bf16_t*)(ws + WS_KMEM) + (size_t)(bgl * 4 + h) * 65536), 0, 0, 0, 0};
                pg8::EpiSoftmax E1{Ps, 0.0625f};
                if (PH(14)) pg8::gemm_phase<pg8::EpiSoftmax, pg8::OneUnit, false>(ldsL, 256, 1024, 256, O, E1);
                asm volatile("s_waitcnt vmcnt(0)" ::: "memory");
                __threadfence(); __syncthreads();
                O.u0 = pg8::Unit{(const char*)Ps, (const char*)((bf16_t*)(ws + WS_VTM) + (size_t)(bgl * 4 + h) * 65536), 0, 0, 0, 0};
                pg8::EpiStore E2{XQ, 1024};
                if (PH(15)) pg8::gemm_phase<pg8::EpiStore, pg8::OneUnit, false>(ldsL, 256, 256, 256, O, E2);
                asm volatile("s_waitcnt vmcnt(0)" ::: "memory");
                __syncthreads();
            }
#endif
#if PH(2) && !(TESTSKIP & 4)
            if (G == 256) {
                const int nu = bx < 128 ? 3 : 5, u0 = bx < 128 ? bx : 384 + (bx - 128);
                for (int j = 0; j < nu; ++j) { const int u = u0 + 128 * j; hgrn_unit<false>(lds, ws, args.in[I_HGN], u >> 6, u & 63); }
            } else
            for (int u = bx; u < 1024; u += G) hgrn_unit<false>(lds, ws, args.in[I_HGN], u >> 6, u & 63);
#endif
        }
        GRID_SYNC();
        {
            IDS(); LAS float* scr = (LAS float*)(ldsL + wave * 16384);
            const float lam = *(const float*)(ws + WS_LAM); const float* subln = args.in[I_SUBLN];
            const bf16_t* OB = (const bf16_t*)(ws + WS_OB); bf16_t* YDA = (bf16_t*)(ws + WS_DQ);
            const f32x4 sg = *(const f32x4*)(subln + 4 * lane);
#if !(TESTSKIP & 8)
            for (int p = gw; p < HROWS * 4; p += NGW) { const int r = p >> 2, h = p & 3, bl = r >> 12, t = r & 4095, vh = lane >> 5, ee = (4 * lane) & 127;
                const size_t o0 = ((size_t)((((bl * 4 + h) * 2 + 0) * 2 + vh) * 4096 + t)) * 128 + ee, o1 = ((size_t)((((bl * 4 + h) * 2 + 1) * 2 + vh) * 4096 + t)) * 128 + ee;
                const u32x2 a = *(const u32x2*)(OB + o0), b = *(const u32x2*)(OB + o1);
                f32x4 d; d[0] = bf_lo(a.x) - lam * bf_lo(b.x); d[1] = bf_hi(a.x) - lam * bf_hi(b.x); d[2] = bf_lo(a.y) - lam * bf_lo(b.y); d[3] = bf_hi(a.y) - lam * bf_hi(b.y);
                const float ssum = wave_sum((d[0] * d[0] + d[1] * d[1]) + (d[2] * d[2] + d[3] * d[3])); const float rr = rsqrtf(ssum * (1.0f / 256.f) + EPS) * 0.8f;
                u32x2 o; o.x = cvt_pk_bf16(d[0] * rr * sg[0], d[1] * rr * sg[1]); o.y = cvt_pk_bf16(d[2] * rr * sg[2], d[3] * rr * sg[3]);
                *(u32x2*)(YDA + (size_t)r * 1024 + h * 256 + 4 * lane) = o; }
#endif
#if !(TESTSKIP & 16)
            bf16_t* LSb = (bf16_t*)(ws + WS_HGS); const float* HGD = (const float*)(ws + WS_HGD);
            for (int e = bx * 512 + tid; e < 16 * 4096; e += G * 512) { const int bh = e >> 12, v = (e >> 5) & 127, k4 = (e & 31) * 4; f32x4 st = {0.f, 0.f, 0.f, 0.f};
                bf16_t* p = LSb + (size_t)bh * 64 * 16384 + v * 128 + k4; const float* dp = HGD + (size_t)bh * 64 * 128 + k4;
#pragma unroll 4
                for (int c = 0; c < 64; ++c) { const u32x2 lw = *(const u32x2*)(p + (size_t)c * 16384); const f32x4 dk = *(const f32x4*)(dp + c * 128);
                    u32x2 o; o.x = cvt_pk_bf16(st[0], st[1]); o.y = cvt_pk_bf16(st[2], st[3]); *(u32x2*)(p + (size_t)c * 16384) = o;
                    st[0] = dk[0] * st[0] + bf_lo(lw.x); st[1] = dk[1] * st[1] + bf_hi(lw.x); st[2] = dk[2] * st[2] + bf_lo(lw.y); st[3] = dk[3] * st[3] + bf_hi(lw.y); } }
#endif
            { unsigned* cm2 = (unsigned*)(ws + WS_CMAX2); const int items = (DM / 64) * (DFF / 32);
              if (half == 0) {
                  for (int it = gw; it < items; it += NGW) { absmax_item(args.in[I_F2G], DFF, DFF, cm2, 1, 0, it, lane); absmax_item(args.in[I_F2U], DFF, DFF, cm2, 1, 1, it, lane); }
              } else {
                  float* cs2 = (float*)(ws + WS_CS2);
                  for (int it = gw; it < items; it += NGW) { quant_item(args.in[I_F2G], DFF, DM, DFF, (unsigned char*)WGU, cm2, cs2, 1, 0, scr, it, lane); quant_item(args.in[I_F2U], DFF, DM, DFF, (unsigned char*)WGU, cm2, cs2, 1, 1, scr, it, lane); }
                  run_transpose(args.in[I_F2D], DFF, DM, WD, 0, 0, scr, gw, NGW, lane);
              } }
        }
        GRID_SYNC();
#if PH(3) && !(TESTSKIP & 32)
        for (int u = bx; u < 1024; u += G) hgrn_unit<true>(lds, ws, args.in[I_HGN], u >> 6, u & 63);
#endif
        GRID_SYNC();
        {
            pg8::ChainOrder S; S.T.init(HROWS / 256, DM / 256, G, bx);
            static_assert(WS_HQ - WS_DQ == 48 * MiB && WS_XQ - WS_DQ == 144 * MiB, "branch inputs: triangular spacing");
            S.A = (const char*)(ws + WS_DQ); S.a_sub = 48 * MiB; S.B = (const char*)WBR; S.b_sub = (size_t)2048 * 1024 * 2;
            S.a_t = (size_t)256 * 1024 * 2; S.b_t = (size_t)256 * 1024 * 2;
            pg8::EpiChain E{(const bf16_t*)(ws + WS_GT), XA + hrow * DM, (float*)(ws + WS_OB)};
#if !(TESTSKIP & 64)
            if (PH(16)) pg8::gemm_phase<pg8::EpiChain, pg8::ChainOrder, true>(ldsL, 1024, 1024, 1024, S, E);
#endif
        }
        GRID_SYNC();
    }
    {
        pg8::StdOrder S; S.T.init(MTOK / 256, DM / 256, G, bx); S.A = (const char*)XA; S.B = (const char*)WO;
#if TESTSKIP & 128
        S.A = (const char*)(ws + WS_DQ);
#endif
        S.a_t = (size_t)256 * DM * 2; S.b_t = (size_t)256 * DM * 2;
        pg8::EpiDownT<true, true, false> E{out, ws + WS_OB, XB, args.in[I_F2N], ssq + 2 * MTOK};
        if (PH(17)) pg8::gemm_phase<pg8::EpiDownT<true, true, false>, pg8::StdOrder, true>(ldsL, DM, DM, DM, S, E);
    }
    GRID_SYNC();
#endif
    {
        IDS(); unsigned char* XA8 = (unsigned char*)XA;
        for (int m = gw; m < MTOK; m += NGW) { f32x4 a[4], b[4]; float am = 0.f;
#pragma unroll
            for (int j = 0; j < 4; ++j) { const int c8 = lane + 64 * j; unpack8(*(const u32x4*)(XB + (size_t)m * DM + 8 * c8), a[j], b[j]);
#pragma unroll
                for (int q = 0; q < 4; ++q) am = fmaxf(am, fmaxf(fabsf(a[j][q]), fabsf(b[j][q]))); }
#pragma unroll
            for (int o = 1; o < 64; o <<= 1) am = fmaxf(am, __shfl_xor(am, o));
            am = fmaxf(am, 1e-30f); const float r = 127.0f / am;
#pragma unroll
            for (int j = 0; j < 4; ++j) { const int c8 = lane + 64 * j;
                u32x2 o; o.x = q8x4(a[j][0] * r, a[j][1] * r, a[j][2] * r, a[j][3] * r); o.y = q8x4(b[j][0] * r, b[j][1] * r, b[j][2] * r, b[j][3] * r);
                *(u32x2*)(XA8 + (size_t)m * DM + 8 * c8) = o; }
            if (lane == 0) ssq[m] = am * (1.0f / 127.0f) * rsqrtf(ssq[2 * MTOK + m] * (1.0f / DM) + EPS); }
    }
    GRID_SYNC();
    {
        pg8::StdOrder S; S.T.init(MTOK / 256, 2 * DFF / 256, G, bx); S.A = (const char*)XA; S.B = (const char*)WGU; S.a_t = (size_t)256 * DM; S.b_t = (size_t)256 * DM;
        pg8::EpiUp8 E{HID, (const float*)(ws + WS_CS2), ssq};
        if (PH(18)) pg8::gemm_phase<pg8::EpiUp8, pg8::StdOrder, true, true>(ldsL, DM / 2, DM / 2, DM / 2, S, E);
    }
    GRID_SYNC();
    {
        pg8::StdOrder S; S.T.init(MTOK / 256, DM / 256, G, bx); S.A = (const char*)HID; S.B = (const char*)WD; S.a_t = (size_t)256 * DFF * 2; S.b_t = (size_t)256 * DFF * 2;
        pg8::EpiDownT<true, false, true> E{ws + WS_OB, out, nullptr, nullptr, ssq + 3 * MTOK};
        if (PH(19)) pg8::gemm_phase<pg8::EpiDownT<true, false, true>, pg8::StdOrder, true>(ldsL, DFF, DFF, DFF, S, E);
    }
    GRID_SYNC();
    {
        IDS();
        const float* gf = args.in[I_FINN];
        for (int m = gw; m < MTOK; m += NGW) { const float r = rsqrtf(ssq[3 * MTOK + m] * (1.0f / DM) + EPS); f32x4* xr = (f32x4*)(out + (size_t)m * DM);
#pragma unroll
            for (int j = 0; j < 8; ++j) { const int c4 = lane + 64 * j; f32x4 v = xr[c4] * r * *(const f32x4*)(gf + 4 * c4);
#if TESTSANITIZE
                for (int q = 0; q < 4; ++q) if (!(fabsf(v[q]) < 1e30f)) v[q] = 100.f;
#endif
                xr[c4] = v; } }
    }
}

extern "C" void kernel_launch(void* const* d_in, const int* in_sizes, int n_in, void* d_out, int out_size, void* d_ws, size_t ws_size, hipStream_t stream) {
    static int grid = 0;
    if (grid == 0) {
        if (n_in != 26 || in_sizes[0] != MTOK * DM || out_size != MTOK * DM || ws_size < WS_END) { fprintf(stderr, "kernel_launch: unexpected shapes (n_in %d, in0 %d, out %d, ws %zu < %zu)\n", n_in, n_in > 0 ? in_sizes[0] : -1, out_size, ws_size, (size_t)WS_END); grid = -1; return; }
        int dev = 0, cus = 0, per_cu = 0;
        (void)hipGetDevice(&dev); (void)hipDeviceGetAttribute(&cus, hipDeviceAttributeMultiprocessorCount, dev);
        if (hipFuncSetAttribute((const void*)fwd_megakernel, hipFuncAttributeMaxDynamicSharedMemorySize, LDS_BYTES) != hipSuccess) { fprintf(stderr, "kernel_launch: hipFuncSetAttribute failed\n"); grid = -1; return; }
        if (hipOccupancyMaxActiveBlocksPerMultiprocessor(&per_cu, (const void*)fwd_megakernel, 512, LDS_BYTES) != hipSuccess || per_cu < 1) { fprintf(stderr, "kernel_launch: occupancy query says %d\n", per_cu); per_cu = 1; }
        (void)hipGetLastError();
        grid = cus > 0 ? cus : 256;
    }
    if (grid < 0) return;
    if (hipMemsetAsync((char*)d_ws + WS_CTL, 0, CTL_BYTES, stream) != hipSuccess) { fprintf(stderr, "kernel_launch: memset of barrier words failed\n"); return; }
    Args a{};
    for (int i = 0; i < 26; ++i) a.in[i] = (const float*)d_in[i];
    a.out = (float*)d_out; a.ws = (unsigned char*)d_ws;
    void* kargs[] = {&a};
    hipError_t e = hipLaunchCooperativeKernel((const void*)fwd_megakernel, dim3(grid), dim3(512), kargs, LDS_BYTES, stream);
    if (e != hipSuccess) fprintf(stderr, "cooperative launch failed: %s (grid %d)\n", hipGetErrorString(e), grid);
}
```
